# Optimizing an MI355X kernel written in HIP

```python
import jax, jax.numpy as jnp
from jax import lax
import numpy as np

D_MODEL = 1024
BATCH = 8
SEQ = 2048
DEPTH = 1

CONV_WIDTH = D_MODEL // 2
CONV_K = 3
GLA_HEADS = 4
GLA_DV = (D_MODEL // 2) // GLA_HEADS
GLA_DK = GLA_DV // 2
GLA_K = GLA_HEADS * GLA_DK
GLA_V = GLA_HEADS * GLA_DV
GLA_GATE_RANK = 16
GLA_TAU = 16.0
GLA_CHUNK = 64
MIX_WIDTH = CONV_WIDTH + GLA_V
IN_COLS = 3 * CONV_WIDTH + 2 * GLA_K + 2 * GLA_V + GLA_GATE_RANK

PEER_HEADS = 8
PEER_N_KEYS = 128
PEER_N_EXPERTS = PEER_N_KEYS * PEER_N_KEYS
PEER_TOPK = 16
PEER_QDIM = 256
PEER_HALF = PEER_QDIM // 2
PEER_BLOCK = 128

LN_EPS = 1e-5
RMS_EPS = 1e-6

kernel_name = "hybrid_conv_gla_peer_deepnorm_adaln"


def _layernorm(x, g, b):
    xf = x.astype(jnp.float32)
    mu = jnp.mean(xf, axis=-1, keepdims=True)
    var = jnp.mean(jnp.square(xf - mu), axis=-1, keepdims=True)
    return ((xf - mu) * lax.rsqrt(var + LN_EPS) * g.astype(jnp.float32)
            + b.astype(jnp.float32)).astype(x.dtype)


def _short_conv_mixer(gate_b, gate_c, hval, conv_w):
    u = gate_c * hval
    seq = u.shape[1]
    up = jnp.pad(u, ((0, 0), (CONV_K - 1, 0), (0, 0)))
    z = sum(conv_w[j] * up[:, j:j + seq] for j in range(CONV_K))
    return gate_b * z


def _gla_chunked(q, k, v, g):
    bsz, seq, nh, dk = q.shape
    dv = v.shape[-1]
    nc = seq // GLA_CHUNK

    def to_chunks(a):
        return a.reshape(bsz, nc, GLA_CHUNK, nh, a.shape[-1]).transpose(0, 3, 1, 2, 4)

    q, k, v, g = (to_chunks(a.astype(jnp.float32)) for a in (q, k, v, g))
    b = jnp.cumsum(g, axis=3)
    b_last = b[:, :, :, -1:, :]
    qe = q * jnp.exp(b)
    ke = k * jnp.exp(-b)
    kl = k * jnp.exp(b_last - b)

    causal = jnp.tril(jnp.ones((GLA_CHUNK, GLA_CHUNK), dtype=bool))
    attn = jnp.einsum('bhncd,bhnmd->bhncm', qe, ke)
    attn = jnp.where(causal, attn, 0.0)
    o_intra = jnp.einsum('bhncm,bhnme->bhnce', attn, v)

    kv = jnp.einsum('bhncd,bhnce->bhnde', kl, v)
    decay = jnp.exp(b_last[:, :, :, 0, :])

    def step(state, inp):
        kv_n, dec_n = inp
        return dec_n[..., None] * state + kv_n, state

    init = jnp.zeros((bsz, nh, dk, dv), jnp.float32)
    _, s_prev = lax.scan(step, init, (jnp.moveaxis(kv, 2, 0), jnp.moveaxis(decay, 2, 0)))
    s_prev = jnp.moveaxis(s_prev, 0, 2)
    o_inter = jnp.einsum('bhncd,bhnde->bhnce', qe, s_prev)

    o = o_intra + o_inter
    return o.transpose(0, 2, 3, 1, 4).reshape(bsz, seq, nh, dv)


def _peer(h, peer_wq, peer_subkeys, peer_u, peer_v):
    bsz, seq, dm = h.shape
    ntok = bsz * seq
    t = h.reshape(ntok, dm)
    q = (t @ peer_wq).reshape(ntok, PEER_HEADS, 2, PEER_HALF)
    s = jnp.einsum('thpd,hpnd->thpn', q.astype(jnp.float32), peer_subkeys.astype(jnp.float32))
    s1, i1 = lax.top_k(s[:, :, 0], PEER_TOPK)
    s2, i2 = lax.top_k(s[:, :, 1], PEER_TOPK)
    cand = (s1[..., :, None] + s2[..., None, :]).reshape(ntok, PEER_HEADS, PEER_TOPK * PEER_TOPK)
    cidx = (i1[..., :, None] * PEER_N_KEYS + i2[..., None, :]).reshape(ntok, PEER_HEADS, PEER_TOPK * PEER_TOPK)
    top, pos = lax.top_k(cand, PEER_TOPK)
    idx = jnp.take_along_axis(cidx, pos, axis=-1)
    gate = jax.nn.softmax(top, axis=-1).astype(h.dtype)

    nb = ntok // PEER_BLOCK

    def block(args):
        tb, ib, gb = args
        u = peer_u[ib]
        a = jax.nn.gelu(jnp.einsum('thkd,td->thk', u, tb), approximate=False)
        vv = peer_v[ib]
        return jnp.einsum('thk,thkd->td', gb * a, vv)

    out = lax.map(block, (t.reshape(nb, PEER_BLOCK, dm),
                          idx.reshape(nb, PEER_BLOCK, PEER_HEADS, PEER_TOPK),
                          gate.reshape(nb, PEER_BLOCK, PEER_HEADS, PEER_TOPK)))
    return out.reshape(bsz, seq, dm)


def setup_inputs(seed: int = 0) -> dict:
    key = jax.random.key(seed)
    ks = jax.random.split(key, 20)
    beta = (8.0 * DEPTH) ** -0.25
    f32 = jnp.float32
    nrm = lambda k, shape, s: (jax.random.normal(k, shape, f32) * s)
    return {
        "x": nrm(ks[0], (BATCH, SEQ, D_MODEL), 1.0),
        "c": nrm(ks[1], (BATCH, D_MODEL), 1.0),
        "w_mod": nrm(ks[2], (D_MODEL, 6 * D_MODEL), 0.5 * D_MODEL ** -0.5),
        "b_mod": nrm(ks[3], (6 * D_MODEL,), 0.02),
        "w_in": nrm(ks[4], (D_MODEL, IN_COLS), D_MODEL ** -0.5),
        "conv_w": nrm(ks[5], (CONV_K, CONV_WIDTH), CONV_K ** -0.5),
        "gla_gate_up": nrm(ks[6], (GLA_GATE_RANK, GLA_K), GLA_GATE_RANK ** -0.5),
        "gla_gate_bias": nrm(ks[7], (GLA_K,), 0.1),
        "gla_norm_g": 1.0 + nrm(ks[8], (GLA_V,), 0.02),
        "w_out": nrm(ks[9], (MIX_WIDTH, D_MODEL), beta * MIX_WIDTH ** -0.5),
        "ln1_g": 1.0 + nrm(ks[10], (D_MODEL,), 0.02),
        "ln1_b": nrm(ks[11], (D_MODEL,), 0.02),
        "peer_wq": nrm(ks[12], (D_MODEL, PEER_HEADS * PEER_QDIM), D_MODEL ** -0.5),
        "peer_subkeys": nrm(ks[13], (PEER_HEADS, 2, PEER_N_KEYS, PEER_HALF), PEER_HALF ** -0.5),
        "peer_u": nrm(ks[14], (PEER_N_EXPERTS, D_MODEL), D_MODEL ** -0.5),
        "peer_v": nrm(ks[15], (PEER_N_EXPERTS, D_MODEL), beta),
        "ln2_g": 1.0 + nrm(ks[16], (D_MODEL,), 0.02),
        "ln2_b": nrm(ks[17], (D_MODEL,), 0.02),
    }


def reference(x, c, w_mod, b_mod, w_in, conv_w, gla_gate_up, gla_gate_bias, gla_norm_g,
              w_out, ln1_g, ln1_b, peer_wq, peer_subkeys, peer_u, peer_v, ln2_g, ln2_b):
    alpha = (2.0 * DEPTH) ** 0.25
    bsz, seq, _ = x.shape
    for _layer in range(DEPTH):
        mod = jax.nn.silu(c) @ w_mod + b_mod
        shift1, scale1, gate1, shift2, scale2, gate2 = (m[:, None, :] for m in jnp.split(mod, 6, axis=-1))

        h = x * (1.0 + scale1) + shift1
        proj = h @ w_in
        offs = np.cumsum([CONV_WIDTH, CONV_WIDTH, CONV_WIDTH, GLA_K, GLA_K, GLA_V, GLA_V]).tolist()
        cb, cc, ch, q, k, v, r, glr = jnp.split(proj, offs, axis=-1)

        y_conv = _short_conv_mixer(cb, cc, ch, conv_w)

        log_a = jax.nn.log_sigmoid((glr @ gla_gate_up + gla_gate_bias).astype(jnp.float32)) / GLA_TAU
        o = _gla_chunked(q.reshape(bsz, seq, GLA_HEADS, GLA_DK) * (GLA_DK ** -0.5),
                         k.reshape(bsz, seq, GLA_HEADS, GLA_DK),
                         v.reshape(bsz, seq, GLA_HEADS, GLA_DV),
                         log_a.reshape(bsz, seq, GLA_HEADS, GLA_DK))
        o = o * lax.rsqrt(jnp.mean(jnp.square(o), axis=-1, keepdims=True) + RMS_EPS)
        o = o.reshape(bsz, seq, GLA_V) * gla_norm_g.astype(jnp.float32)
        y_gla = (o * jax.nn.silu(r.astype(jnp.float32))).astype(x.dtype)

        y_mix = jnp.concatenate([y_conv, y_gla], axis=-1) @ w_out
        x = _layernorm(alpha * x + (1.0 + gate1) * y_mix, ln1_g, ln1_b)

        h2 = x * (1.0 + scale2) + shift2
        y_ffn = _peer(h2, peer_wq, peer_subkeys, peer_u, peer_v)
        x = _layernorm(alpha * x + (1.0 + gate2) * y_ffn, ln2_g, ln2_b)
    return x
```

```cpp
#include <hip/hip_runtime.h>
#include <cstdio>
#include <cstdint>
#include <cmath>

namespace {
constexpr int D = 1024, BATCH = 8, SEQ = 2048, M = BATCH * SEQ;
constexpr int CONVW = 512, GK = 256, GV = 512, NH = 4, DK = 64, DV = 128, RANK = 16;
constexpr int INC = 3088;
constexpr int PH = 8, NKEYS = 128, TOPK = 16, QD = 256, HALFD = 128;
constexpr float LN_EPS = 1e-5f, RMS_EPS = 1e-6f;
constexpr float ALPHA = 1.189207115002721f;
constexpr size_t MiB = 1u << 20;
constexpr size_t WS_PROJ = 0, WS_LOGA = 204 * MiB, WS_MOD = 250 * MiB;
constexpr size_t WS_Y = 0, WS_X1 = 64 * MiB, WS_QH = 128 * MiB, WS_IDX = 0, WS_GATE = 8 * MiB;

__device__ __forceinline__ float silu_f(float v) { return v / (1.f + expf(-v)); }
__device__ __forceinline__ float gelu_f(float v) { return 0.5f * v * (1.f + erff(v * 0.70710678118654752f)); }
__device__ __forceinline__ float logsig_f(float z) { return fminf(z, 0.f) - log1pf(expf(-fabsf(z))); }

__global__ void k_mod(const float* c, const float* w_mod, const float* b_mod, float* mod) {
    int n = blockIdx.x * 256 + threadIdx.x; int b = blockIdx.y;
    __shared__ float sc[D];
    for (int k = threadIdx.x; k < D; k += 256) sc[k] = silu_f(c[b * D + k]);
    __syncthreads();
    float acc = 0.f;
    for (int k = 0; k < D; ++k) acc += sc[k] * w_mod[(size_t)k * (6 * D) + n];
    mod[b * 6 * D + n] = acc + b_mod[n];
}

template <int MODE>
__global__ void __launch_bounds__(256) k_gemm(const float* __restrict__ A, const float* __restrict__ B, float* __restrict__ C, int Mm, int N, int K, int lda, int ldb, int ldc,
                                             const float* scale, const float* shift, int modstride) {
    __shared__ float As[16][68];
    __shared__ float Bs[16][68];
    const int tid = threadIdx.x, tx = tid & 15, ty = tid >> 4;
    const int m0 = blockIdx.y * 64, n0 = blockIdx.x * 64;
    float acc[4][4] = {};
    const int am = tid >> 2, ak = (tid & 3) * 4;
    const int bk = tid >> 4, bn = (tid & 15) * 4;
    const int bidx = (m0 + am) / SEQ;
    for (int k0 = 0; k0 < K; k0 += 16) {
        float4 a = *(const float4*)(A + (size_t)(m0 + am) * lda + k0 + ak);
        if (MODE == 1) {
            const float* sc = scale + (size_t)bidx * modstride + k0 + ak; const float* sh = shift + (size_t)bidx * modstride + k0 + ak;
            a.x = a.x * (1.f + sc[0]) + sh[0]; a.y = a.y * (1.f + sc[1]) + sh[1]; a.z = a.z * (1.f + sc[2]) + sh[2]; a.w = a.w * (1.f + sc[3]) + sh[3];
        }
        As[ak + 0][am] = a.x; As[ak + 1][am] = a.y; As[ak + 2][am] = a.z; As[ak + 3][am] = a.w;
        float4 b = make_float4(0.f, 0.f, 0.f, 0.f);
        if (n0 + bn < N) b = *(const float4*)(B + (size_t)(k0 + bk) * ldb + n0 + bn);
        *(float4*)&Bs[bk][bn] = b;
        __syncthreads();
#pragma unroll
        for (int kk = 0; kk < 16; ++kk) {
            float4 av = *(const float4*)&As[kk][ty * 4]; float4 bv = *(const float4*)&Bs[kk][tx * 4];
            float aa[4] = {av.x, av.y, av.z, av.w}, bb[4] = {bv.x, bv.y, bv.z, bv.w};
#pragma unroll
            for (int i = 0; i < 4; ++i)
#pragma unroll
                for (int j = 0; j < 4; ++j) acc[i][j] += aa[i] * bb[j];
        }
        __syncthreads();
    }
    if (n0 + tx * 4 < N) {
#pragma unroll
        for (int i = 0; i < 4; ++i) *(float4*)(C + (size_t)(m0 + ty * 4 + i) * ldc + n0 + tx * 4) = make_float4(acc[i][0], acc[i][1], acc[i][2], acc[i][3]);
    }
}

__global__ void k_conv(const float* proj, const float* conv_w, float* ymix) {
    int idx = blockIdx.x * 256 + threadIdx.x;
    int m = idx >> 9, c = idx & 511; int s = m % SEQ;
    float z = 0.f;
#pragma unroll
    for (int j = 0; j < 3; ++j) { int sp = s - 2 + j; if (sp >= 0) { const float* pr = proj + (size_t)(m - 2 + j) * INC; z += conv_w[j * CONVW + c] * pr[CONVW + c] * pr[2 * CONVW + c]; } }
    ymix[(size_t)m * D + c] = proj[(size_t)m * INC + c] * z;
}

__global__ void k_loga(const float* proj, const float* gate_up, const float* gate_bias, float* loga) {
    int idx = blockIdx.x * 256 + threadIdx.x; int m = idx >> 8, cidx = idx & 255;
    const float* glr = proj + (size_t)m * INC + 3072;
    float z = gate_bias[cidx];
#pragma unroll
    for (int j = 0; j < RANK; ++j) z += glr[j] * gate_up[j * GK + cidx];
    loga[idx] = logsig_f(z) * (1.f / 16.f);
}

__global__ void __launch_bounds__(128) k_gla(const float* proj, const float* loga, const float* norm_g, float* ymix) {
    const int b = blockIdx.x >> 2, h = blockIdx.x & 3, e = threadIdx.x;
    __shared__ float sq[DK], sk[DK], sg[DK], red[2];
    float S[DK];
#pragma unroll
    for (int d = 0; d < DK; ++d) S[d] = 0.f;
    for (int t = 0; t < SEQ; ++t) {
        const size_t m = (size_t)b * SEQ + t; const float* pr = proj + m * INC;
        if (e < DK) { sq[e] = pr[1536 + h * DK + e] * 0.125f; sk[e] = pr[1792 + h * DK + e]; sg[e] = expf(loga[m * GK + h * DK + e]); }
        const float v = pr[2048 + h * DV + e]; const float r = pr[2560 + h * DV + e];
        __syncthreads();
        float o = 0.f;
#pragma unroll
        for (int d = 0; d < DK; ++d) { S[d] = sg[d] * S[d] + sk[d] * v; o += sq[d] * S[d]; }
        float ss = o * o;
        for (int off = 32; off >= 1; off >>= 1) ss += __shfl_xor(ss, off);
        if ((e & 63) == 0) red[e >> 6] = ss;
        __syncthreads();
        const float ms = (red[0] + red[1]) * (1.f / DV);
        const float on = o * rsqrtf(ms + RMS_EPS) * norm_g[h * DV + e];
        ymix[m * D + CONVW + h * DV + e] = on * silu_f(r);
        __syncthreads();
    }
}

__global__ void __launch_bounds__(256) k_ln1(const float* x, const float* y, const float* mod, const float* g, const float* bb, float* x1) {
    const int m = blockIdx.x, b = m / SEQ, tid = threadIdx.x;
    __shared__ float red[8];
    const float* gate1 = mod + (size_t)b * 6 * D + 2 * D;
    float v[4]; float s = 0.f;
#pragma unroll
    for (int i = 0; i < 4; ++i) { int c = tid + 256 * i; v[i] = ALPHA * x[(size_t)m * D + c] + (1.f + gate1[c]) * y[(size_t)m * D + c]; s += v[i]; }
    for (int off = 32; off >= 1; off >>= 1) s += __shfl_xor(s, off);
    if ((tid & 63) == 0) red[tid >> 6] = s;
    __syncthreads();
    const float mean = (red[0] + red[1] + red[2] + red[3]) * (1.f / D);
    float q = 0.f;
#pragma unroll
    for (int i = 0; i < 4; ++i) { v[i] -= mean; q += v[i] * v[i]; }
    for (int off = 32; off >= 1; off >>= 1) q += __shfl_xor(q, off);
    if ((tid & 63) == 0) red[4 + (tid >> 6)] = q;
    __syncthreads();
    const float rstd = rsqrtf((red[4] + red[5] + red[6] + red[7]) * (1.f / D) + LN_EPS);
#pragma unroll
    for (int i = 0; i < 4; ++i) { int c = tid + 256 * i; x1[(size_t)m * D + c] = v[i] * rstd * g[c] + bb[c]; }
}

__global__ void __launch_bounds__(256) k_route(const float* qh, const float* subkeys, int h0, int* idx_out, float* gate_out) {
    const int t = blockIdx.x >> 2, hl = blockIdx.x & 3, h = h0 + hl, tid = threadIdx.x;
    __shared__ float q[QD], s[2][NKEYS], tv[2][TOPK], cand[256], top[TOPK], ev[TOPK];
    __shared__ int ti[2][TOPK], pos[TOPK];
    q[tid] = qh[(size_t)t * 1024 + hl * QD + tid];
    __syncthreads();
    {
        const int p = tid >> 7, n = tid & 127; const float* kr = subkeys + (((size_t)h * 2 + p) * NKEYS + n) * HALFD;
        float acc = 0.f;
        for (int d = 0; d < HALFD; ++d) acc += q[p * HALFD + d] * kr[d];
        s[p][n] = acc;
    }
    __syncthreads();
    if ((tid & 127) == 0) {
        const int p = tid >> 7;
        for (int i = 0; i < TOPK; ++i) {
            float best = -INFINITY; int bi = 0;
            for (int n = 0; n < NKEYS; ++n) { float vv = s[p][n]; if (vv > best) { best = vv; bi = n; } }
            tv[p][i] = best; ti[p][i] = bi; s[p][bi] = -INFINITY;
        }
    }
    __syncthreads();
    cand[tid] = tv[0][tid >> 4] + tv[1][tid & 15];
    __syncthreads();
    if (tid == 0) {
        for (int i = 0; i < TOPK; ++i) {
            float best = -INFINITY; int bi = 0;
            for (int n = 0; n < 256; ++n) { float vv = cand[n]; if (vv > best) { best = vv; bi = n; } }
            top[i] = best; pos[i] = bi; cand[bi] = -INFINITY;
        }
        float sum = 0.f;
        for (int i = 0; i < TOPK; ++i) { ev[i] = expf(top[i] - top[0]); sum += ev[i]; }
        const float inv = 1.f / sum;
        for (int i = 0; i < TOPK; ++i) {
            idx_out[((size_t)t * PH + h) * TOPK + i] = ti[0][pos[i] >> 4] * NKEYS + ti[1][pos[i] & 15];
            gate_out[((size_t)t * PH + h) * TOPK + i] = ev[i] * inv;
        }
    }
}

__global__ void __launch_bounds__(256) k_peer(const float* x1, const float* mod, const int* idx, const float* gate, const float* pu, const float* pv,
                                              const float* g2, const float* b2, float* out) {
    const int t = blockIdx.x, b = t / SEQ, tid = threadIdx.x, lane = tid & 63, w = tid >> 6;
    __shared__ float h2[D], wgt[128], red[8];
    __shared__ int eid[128];
    const float* mrow = mod + (size_t)b * 6 * D;
    for (int c = tid; c < D; c += 256) h2[c] = x1[(size_t)t * D + c] * (1.f + mrow[4 * D + c]) + mrow[3 * D + c];
    if (tid < 128) eid[tid] = idx[(size_t)t * 128 + tid];
    __syncthreads();
    for (int j = w; j < 128; j += 4) {
        const float* ur = pu + (size_t)eid[j] * D; float acc = 0.f;
#pragma unroll
        for (int i = 0; i < 4; ++i) { float4 uv = *(const float4*)(ur + lane * 4 + 256 * i); const float* hh = h2 + lane * 4 + 256 * i; acc += uv.x * hh[0] + uv.y * hh[1] + uv.z * hh[2] + uv.w * hh[3]; }
        for (int off = 32; off >= 1; off >>= 1) acc += __shfl_xor(acc, off);
        if (lane == 0) wgt[j] = gate[(size_t)t * 128 + j] * gelu_f(acc);
    }
    __syncthreads();
    float4 acc = make_float4(0.f, 0.f, 0.f, 0.f);
    for (int j = 0; j < 128; ++j) { const float ww = wgt[j]; float4 vv = *(const float4*)(pv + (size_t)eid[j] * D + tid * 4); acc.x += ww * vv.x; acc.y += ww * vv.y; acc.z += ww * vv.z; acc.w += ww * vv.w; }
    const float* gate2 = mrow + 5 * D;
    float4 xv = *(const float4*)(x1 + (size_t)t * D + tid * 4);
    float v[4] = {ALPHA * xv.x + (1.f + gate2[tid * 4 + 0]) * acc.x, ALPHA * xv.y + (1.f + gate2[tid * 4 + 1]) * acc.y, ALPHA * xv.z + (1.f + gate2[tid * 4 + 2]) * acc.z, ALPHA * xv.w + (1.f + gate2[tid * 4 + 3]) * acc.w};
    float s = v[0] + v[1] + v[2] + v[3];
    for (int off = 32; off >= 1; off >>= 1) s += __shfl_xor(s, off);
    if (lane == 0) red[w] = s;
    __syncthreads();
    const float mean = (red[0] + red[1] + red[2] + red[3]) * (1.f / D);
    float q = 0.f;
#pragma unroll
    for (int i = 0; i < 4; ++i) { v[i] -= mean; q += v[i] * v[i]; }
    for (int off = 32; off >= 1; off >>= 1) q += __shfl_xor(q, off);
    if (lane == 0) red[4 + w] = q;
    __syncthreads();
    const float rstd = rsqrtf((red[4] + red[5] + red[6] + red[7]) * (1.f / D) + LN_EPS);
    float4 o;
    o.x = v[0] * rstd * g2[tid * 4 + 0] + b2[tid * 4 + 0]; o.y = v[1] * rstd * g2[tid * 4 + 1] + b2[tid * 4 + 1];
    o.z = v[2] * rstd * g2[tid * 4 + 2] + b2[tid * 4 + 2]; o.w = v[3] * rstd * g2[tid * 4 + 3] + b2[tid * 4 + 3];
    *(float4*)(out + (size_t)t * D + tid * 4) = o;
}
}

extern "C" void kernel_launch(void* const* d_in, const int* in_sizes, int n_in, void* d_out, int out_size, void* d_ws, size_t ws_size, hipStream_t stream) {
    const float* x = (const float*)d_in[0]; const float* c = (const float*)d_in[1]; const float* w_mod = (const float*)d_in[2]; const float* b_mod = (const float*)d_in[3];
    const float* w_in = (const float*)d_in[4]; const float* conv_w = (const float*)d_in[5]; const float* gate_up = (const float*)d_in[6]; const float* gate_bias = (const float*)d_in[7];
    const float* norm_g = (const float*)d_in[8]; const float* w_out = (const float*)d_in[9]; const float* ln1_g = (const float*)d_in[10]; const float* ln1_b = (const float*)d_in[11];
    const float* wq = (const float*)d_in[12]; const float* subkeys = (const float*)d_in[13]; const float* pu = (const float*)d_in[14]; const float* pv = (const float*)d_in[15];
    const float* ln2_g = (const float*)d_in[16]; const float* ln2_b = (const float*)d_in[17];
    char* ws = (char*)d_ws; float* out = (float*)d_out;
    float* mod = (float*)(ws + WS_MOD); float* proj = (float*)(ws + WS_PROJ); float* loga = (float*)(ws + WS_LOGA);
    float* ymix = out;
    float* y = (float*)(ws + WS_Y); float* x1 = (float*)(ws + WS_X1); float* qh = (float*)(ws + WS_QH);
    int* idx = (int*)(ws + WS_IDX); float* gate = (float*)(ws + WS_GATE);

    k_mod<<<dim3(6 * D / 256, BATCH), 256, 0, stream>>>(c, w_mod, b_mod, mod);
    k_gemm<1><<<dim3((INC + 63) / 64, M / 64), 256, 0, stream>>>(x, w_in, proj, M, INC, D, D, INC, INC, mod + D, mod, 6 * D);
    k_conv<<<M * CONVW / 256, 256, 0, stream>>>(proj, conv_w, ymix);
    k_loga<<<M * GK / 256, 256, 0, stream>>>(proj, gate_up, gate_bias, loga);
    k_gla<<<BATCH * NH, 128, 0, stream>>>(proj, loga, norm_g, ymix);
    k_gemm<0><<<dim3(D / 64, M / 64), 256, 0, stream>>>(ymix, w_out, y, M, D, D, D, D, D, nullptr, nullptr, 0);
    k_ln1<<<M, 256, 0, stream>>>(x, y, mod, ln1_g, ln1_b, x1);
    for (int hh = 0; hh < 2; ++hh) {
        k_gemm<1><<<dim3(1024 / 64, M / 64), 256, 0, stream>>>(x1, wq + hh * 1024, qh, M, 1024, D, D, 2048, 1024, mod + 4 * D, mod + 3 * D, 6 * D);
        k_route<<<M * 4, 256, 0, stream>>>(qh, subkeys, hh * 4, idx, gate);
    }
    k_peer<<<M, 256, 0, stream>>>(x1, mod, idx, gate, pu, pv, ln2_g, ln2_b, out);
}
```

```cpp
#include <hip/hip_runtime.h>
#include <cstdio>
#include <cstdint>
#include <cmath>
namespace pg8 {
#define PG8_LAS __attribute__((address_space(3)))
typedef unsigned short bf16_t;
typedef short bf16x8 __attribute__((ext_vector_type(8)));
typedef float f32x4 __attribute__((ext_vector_type(4)));
typedef unsigned u32x4 __attribute__((ext_vector_type(4)));
constexpr int BM = 256, BK = 64, HALF = 128, HTB = HALF * BK * 2  , STAGE_BYTES = 8 * HTB, NXCD = 8, WGM = 8;

__host__ __device__ __forceinline__ int lds_byte(int r, int c) { const int st = (r >> 4) * 2 + (c >> 5), rr = r & 15, cc = c & 31, ob = rr * 64 + cc * 2; return st * 1024 + (ob ^ (((ob >> 9) & 1) << 5)); }
__host__ __device__ __forceinline__ void stage_rc(int b, int& R, int& C) { const int st = b / 1024, sb = b % 1024, swz = sb ^ (((sb >> 9) & 1) << 5); R = (st >> 1) * 16 + swz / 64; C = (st & 1) * 32 + (swz % 64) / 2; }
__host__ __device__ __forceinline__ int perm32(int rho) { const int n = rho >> 4, i = rho & 15; return 8 * (i >> 2) + 4 * n + (i & 3); }

struct Unit { int pm, pn; };
struct Gemm { const bf16_t* A; const bf16_t* Bt; int M, N, K; };

struct StaticOrder {
    int nM, nN, nwg, G, c;
    __host__ __device__ void init(int M, int N, int G_, int c_) { nM = M / BM; nN = N / BM; nwg = nM * nN; G = G_; c = c_; }
    __host__ __device__ bool next(int i, Unit& u) const {
        const long L = (long)i * G + c; if (L >= nwg) return false;
        int wgid = (int)L; { const int q = nwg / NXCD, r = nwg % NXCD, xcd = wgid % NXCD, off = wgid / NXCD; wgid = (xcd < r ? xcd * (q + 1) : r * (q + 1) + (xcd - r) * q) + off; }
        const int nig = WGM * nN, gid = wgid / nig, fm = gid * WGM, gsz = (nM - fm) < WGM ? (nM - fm) : WGM;
        u.pm = fm + ((wgid % nig) % gsz); u.pn = (wgid % nig) / gsz; return true;
    }
    __device__ __forceinline__ void a_ready(const Unit&) const {}
    __device__ __forceinline__ void done(const Unit&) const {}
};

__device__ __forceinline__ unsigned cvt_pk_bf16(float lo, float hi) { unsigned r; asm volatile("v_cvt_pk_bf16_f32 %0, %1, %2" : "=v"(r) : "v"(lo), "v"(hi)); return r; }
typedef float f32x2 __attribute__((ext_vector_type(2)));
__device__ __forceinline__ f32x2 gelu_pk(f32x2 v) {
    const f32x2 av = __builtin_elementwise_abs(v), d = av * 0.2316418882f + 1.0f;
    f32x2 t; t.x = __builtin_amdgcn_rcpf(d.x); t.y = __builtin_amdgcn_rcpf(d.y);
    f32x2 q = t * 0.5307027145f + (-0.7265760135f); q = q * t + 0.7107068705f; q = q * t + (-0.142248368f); q = q * t + 0.127414796f; q = q * t;
    const f32x2 s = (v * v) * (-0.72134752044f);
    f32x2 e; e.x = __builtin_amdgcn_exp2f(s.x); e.y = __builtin_amdgcn_exp2f(s.y);
    const f32x2 m = v * (q * e), r = v - m;
    f32x2 o; o.x = v.x < 0.f ? m.x : r.x; o.y = v.y < 0.f ? m.y : r.y; return o;
}

template <int ACT  > struct EpiBf16 {
    static constexpr bool PERM = true, AFTER_DRAIN = false; static_assert(ACT == 0 || ACT == 1, "EpiBf16: ACT is 0 (none) or 1 (gelu_pk)");
    bf16_t* O; int ldc; const float* bias; int split_cols; size_t split_stride; float scale0;
    __device__ __forceinline__ void operator()(const f32x4 (&acc)[2][2][4][2], const Unit& u, int wr, int wc, int fr, int fq) const {
        const int row0 = u.pm * BM + wr * 64 + fr; int colt = u.pn * BM; bf16_t* base = O;
        float sc = 1.f; if (split_cols) { const int t = colt / split_cols; base += (size_t)t * split_stride; colt -= t * split_cols; if (t == 0) sc = scale0; }
        const int col0 = colt + wc * 32 + 8 * fq, bcol0 = u.pn * BM + wc * 32 + 8 * fq;
        f32x4 bv[2][2];
#pragma unroll
        for (int bj = 0; bj < 2; ++bj)
#pragma unroll
            for (int n = 0; n < 2; ++n) bv[bj][n] = bias ? *(const f32x4*)(bias + bcol0 + bj * HALF + 4 * n) : (f32x4){0.f, 0.f, 0.f, 0.f};
#pragma unroll
        for (int ai = 0; ai < 2; ++ai)
#pragma unroll
            for (int m = 0; m < 4; ++m) { bf16_t* rowp = base + (size_t)(row0 + ai * HALF + m * 16) * ldc + col0;
#pragma unroll
                for (int bj = 0; bj < 2; ++bj) { f32x4 v0 = acc[ai][bj][m][0] + bv[bj][0], v1 = acc[ai][bj][m][1] + bv[bj][1];
                    if (ACT == 1) { f32x2 a = gelu_pk((f32x2){v0[0], v0[1]}), b = gelu_pk((f32x2){v0[2], v0[3]}), c = gelu_pk((f32x2){v1[0], v1[1]}), d = gelu_pk((f32x2){v1[2], v1[3]});
                        v0 = (f32x4){a.x, a.y, b.x, b.y}; v1 = (f32x4){c.x, c.y, d.x, d.y}; }
                    v0 = v0 * sc; v1 = v1 * sc; u32x4 w; w.x = cvt_pk_bf16(v0[0], v0[1]); w.y = cvt_pk_bf16(v0[2], v0[3]); w.z = cvt_pk_bf16(v1[0], v1[1]); w.w = cvt_pk_bf16(v1[2], v1[3]);
                    *(u32x4*)(rowp + bj * HALF) = w; } }
    }
};

struct PanelStats {
    unsigned* xbuf;
    unsigned* cnt;
    unsigned* tmo;
    int ntn; float eps;
    unsigned code;
    __device__ __forceinline__ bool run(const f32x4 (&v)[2][2][4][2], const Unit& u, int wr, int wc, int fr, int fq, PG8_LAS unsigned char* lds, int wid, int lane) const {
        typedef float f32x2v __attribute__((ext_vector_type(2)));
        PG8_LAS f32x2v* P = (PG8_LAS f32x2v*)lds;
        PG8_LAS f32x2v* S = (PG8_LAS f32x2v*)(lds + 8192);
        PG8_LAS unsigned* flag = (PG8_LAS unsigned*)(lds + 8192 + 2048);
#pragma unroll
        for (int ai = 0; ai < 2; ++ai)
#pragma unroll
            for (int m = 0; m < 4; ++m) {
                float s = 0.f;
#pragma unroll
                for (int bj = 0; bj < 2; ++bj)
#pragma unroll
                    for (int n = 0; n < 2; ++n) { const f32x4 x = v[ai][bj][m][n]; s += (x[0] + x[1]) + (x[2] + x[3]); }
                s += __shfl_xor(s, 16); s += __shfl_xor(s, 32);
                const float mw = s * (1.0f / 64.0f); float q = 0.f;
#pragma unroll
                for (int bj = 0; bj < 2; ++bj)
#pragma unroll
                    for (int n = 0; n < 2; ++n) { const f32x4 d = v[ai][bj][m][n] - mw; q += (d[0] * d[0] + d[1] * d[1]) + (d[2] * d[2] + d[3] * d[3]); }
                q += __shfl_xor(q, 16); q += __shfl_xor(q, 32);
                if (fq == 0) P[(ai * HALF + wr * 64 + m * 16 + fr) * 4 + wc] = (f32x2v){mw, q};
            }
        asm volatile("s_waitcnt lgkmcnt(0)" ::: "memory"); __builtin_amdgcn_s_barrier(); asm volatile("" ::: "memory");
#if defined(BROKEN_EXCHANGE_NO_WAIT)
#warning BROKEN CONTROL BUILD: the row-statistics exchange does not wait; results are wrong by design
        if (blockIdx.x >= 64) { const long long t0_ = clock64(); while (clock64() - t0_ < 60000) __builtin_amdgcn_s_sleep(8); }
#endif
        const int row = wid * 32 + (lane & 31);
        if (lane < 32) {
            const f32x2v a = P[row * 4 + 0], b = P[row * 4 + 1], c = P[row * 4 + 2], d = P[row * 4 + 3];
            const float mt = (a.x + b.x + c.x + d.x) * 0.25f;
            const float da = a.x - mt, db = b.x - mt, dc = c.x - mt, dd = d.x - mt;
            const float m2 = (a.y + b.y) + (c.y + d.y) + 64.0f * ((da * da + db * db) + (dc * dc + dd * dd));
            unsigned long long* slot = (unsigned long long*)xbuf + ((size_t)(u.pm * BM + row) * 4 + u.pn);
            __hip_atomic_store(slot, ((unsigned long long)__float_as_uint(m2) << 32) | __float_as_uint(mt), __ATOMIC_RELAXED, __HIP_MEMORY_SCOPE_AGENT);
        }
        asm volatile("s_waitcnt vmcnt(0)" ::: "memory");
        if (lane == 0) __hip_atomic_fetch_add(cnt + 64 * u.pm, 1u, __ATOMIC_RELAXED, __HIP_MEMORY_SCOPE_AGENT);
        if (wid == 0) {
            bool dead = false; const unsigned long long t0 = __builtin_amdgcn_s_memrealtime(); const unsigned want = 8u * (unsigned)ntn;
            for (;;) {
#if defined(BROKEN_EXCHANGE_NO_WAIT)
                break;
#endif
                if ((unsigned)__builtin_amdgcn_readfirstlane(__hip_atomic_load(cnt + 64 * u.pm, __ATOMIC_RELAXED, __HIP_MEMORY_SCOPE_AGENT)) >= want) break;
                if (__builtin_amdgcn_s_memrealtime() - t0 > 2000000ull) {
                    if (lane == 0) { unsigned expect = 0u; __hip_atomic_compare_exchange_strong(tmo + 1, &expect, code | (unsigned)(u.pm & 0xff), __ATOMIC_RELAXED, __ATOMIC_RELAXED, __HIP_MEMORY_SCOPE_AGENT);
                                     __hip_atomic_store(tmo, 1u, __ATOMIC_RELAXED, __HIP_MEMORY_SCOPE_AGENT); }
                    dead = true; break; }
                __builtin_amdgcn_s_sleep(2);
            }
            __builtin_amdgcn_fence(__ATOMIC_ACQUIRE, "agent");
            if (lane == 0) flag[0] = dead ? 1u : 0u;
        }
        asm volatile("s_waitcnt vmcnt(0) lgkmcnt(0)" ::: "memory"); __builtin_amdgcn_s_barrier(); asm volatile("" ::: "memory");
        const bool bad = flag[0] != 0u;
        if (lane < 32) {
            const unsigned long long* slot = (const unsigned long long*)xbuf + (size_t)(u.pm * BM + row) * 4; float mt[4], m2[4]; float ms = 0.f;
#pragma unroll
            for (int t = 0; t < 4; ++t) { if (t < ntn) { const unsigned long long w = __hip_atomic_load(slot + t, __ATOMIC_RELAXED, __HIP_MEMORY_SCOPE_AGENT); mt[t] = __uint_as_float((unsigned)w); m2[t] = __uint_as_float((unsigned)(w >> 32)); } else { mt[t] = 0.f; m2[t] = 0.f; } ms += mt[t]; }
            const float mean = ms / (float)ntn; float q = 0.f;
#pragma unroll
            for (int t = 0; t < 4; ++t) if (t < ntn) { const float dm = mt[t] - mean; q += m2[t] + 256.0f * dm * dm; }
            S[row] = (f32x2v){mean, 1.0f / sqrtf(q / (256.0f * (float)ntn) + eps)};
        }
        asm volatile("s_waitcnt lgkmcnt(0)" ::: "memory"); __builtin_amdgcn_s_barrier(); asm volatile("" ::: "memory");
        return bad;
    }
};
struct EpiLnRes {
    static constexpr bool PERM = false, AFTER_DRAIN = true;
    const float* base; float* out; int ldc; const float* bias; PanelStats st; unsigned poison;
    __device__ __forceinline__ void fused(f32x4 (&acc)[2][2][4][2], const Unit& u, int wr, int wc, int fr, int fq, PG8_LAS unsigned char* lds, int wid, int lane) const {
        typedef float f32x2v __attribute__((ext_vector_type(2)));
        const PG8_LAS f32x2v* S = (const PG8_LAS f32x2v*)(lds + 8192);
        const int col0 = u.pn * BM + wc * 32 + 4 * fq;
#pragma unroll
        for (int bj = 0; bj < 2; ++bj)
#pragma unroll
            for (int n = 0; n < 2; ++n) { const f32x4 bv = bias ? *(const f32x4*)(bias + col0 + bj * HALF + n * 16) : (f32x4){0.f, 0.f, 0.f, 0.f};
#pragma unroll
                for (int ai = 0; ai < 2; ++ai)
#pragma unroll
                    for (int m = 0; m < 4; ++m) acc[ai][bj][m][n] += bv; }
        f32x4 pre[4][2][2];
#pragma unroll
        for (int m = 0; m < 4; ++m) { const size_t off = (size_t)(u.pm * BM + wr * 64 + m * 16 + fr) * ldc + col0;
#pragma unroll
            for (int bj = 0; bj < 2; ++bj)
#pragma unroll
                for (int n = 0; n < 2; ++n) pre[m][bj][n] = *(const f32x4*)(base + off + bj * HALF + n * 16); }
        const bool bad = st.run(acc, u, wr, wc, fr, fq, lds, wid, lane) || poison != 0u;
        const float qnan = __builtin_nanf("");
#pragma unroll
        for (int ai = 0; ai < 2; ++ai)
#pragma unroll
            for (int m = 0; m < 4; ++m) { const int r = ai * HALF + wr * 64 + m * 16 + fr; const f32x2v sr = S[r]; const size_t off = (size_t)(u.pm * BM + r) * ldc + col0;
#pragma unroll
                for (int bj = 0; bj < 2; ++bj)
#pragma unroll
                    for (int n = 0; n < 2; ++n) { const f32x4 bs = ai == 0 ? pre[m][bj][n] : *(const f32x4*)(base + off + bj * HALF + n * 16); f32x4 o = bs + (acc[ai][bj][m][n] - sr.x) * sr.y;
                        if (bad) o = (f32x4){qnan, qnan, qnan, qnan}; *(f32x4*)(out + off + bj * HALF + n * 16) = o; }
                if (m & 1) asm volatile("" ::: "memory"); }
    }
};
struct EpiLnResLn {
    static constexpr bool PERM = false, AFTER_DRAIN = true;
    const float* base; float* out; bf16_t* xn; int ldc; const float* bias; PanelStats st1, st2; unsigned poison;
    __device__ __forceinline__ void fused(f32x4 (&acc)[2][2][4][2], const Unit& u, int wr, int wc, int fr, int fq, PG8_LAS unsigned char* lds, int wid, int lane) const {
        typedef float f32x2v __attribute__((ext_vector_type(2))); typedef unsigned u32x2v __attribute__((ext_vector_type(2)));
        const PG8_LAS f32x2v* S = (const PG8_LAS f32x2v*)(lds + 8192);
        const int col0 = u.pn * BM + wc * 32 + 4 * fq;
#pragma unroll
        for (int bj = 0; bj < 2; ++bj)
#pragma unroll
            for (int n = 0; n < 2; ++n) { const f32x4 bv = bias ? *(const f32x4*)(bias + col0 + bj * HALF + n * 16) : (f32x4){0.f, 0.f, 0.f, 0.f};
#pragma unroll
                for (int ai = 0; ai < 2; ++ai)
#pragma unroll
                    for (int m = 0; m < 4; ++m) acc[ai][bj][m][n] += bv; }
        bool bad = st1.run(acc, u, wr, wc, fr, fq, lds, wid, lane) || poison != 0u;
        const float qnan = __builtin_nanf("");
#pragma unroll
        for (int ai = 0; ai < 2; ++ai)
#pragma unroll
            for (int m = 0; m < 4; ++m) { const int r = ai * HALF + wr * 64 + m * 16 + fr; const f32x2v sr = S[r]; const size_t off = (size_t)(u.pm * BM + r) * ldc + col0;
#pragma unroll
                for (int bj = 0; bj < 2; ++bj)
#pragma unroll
                    for (int n = 0; n < 2; ++n) { const f32x4 bs = *(const f32x4*)(base + off + bj * HALF + n * 16); acc[ai][bj][m][n] = bs + (acc[ai][bj][m][n] - sr.x) * sr.y; }
                asm volatile("" : "+v"(acc[ai][0][m][0]), "+v"(acc[ai][0][m][1]), "+v"(acc[ai][1][m][0]), "+v"(acc[ai][1][m][1]));
                if (m & 1) asm volatile("" ::: "memory"); }
        const bool bad1 = bad;
        bad = st2.run(acc, u, wr, wc, fr, fq, lds, wid, lane) || bad;
#pragma unroll
        for (int ai = 0; ai < 2; ++ai)
#pragma unroll
            for (int m = 0; m < 4; ++m) { const int r = ai * HALF + wr * 64 + m * 16 + fr; const f32x2v sr = S[r]; const size_t off = (size_t)(u.pm * BM + r) * ldc + col0;
#pragma unroll
                for (int bj = 0; bj < 2; ++bj)
#pragma unroll
                    for (int n = 0; n < 2; ++n) { const f32x4 x1 = acc[ai][bj][m][n]; *(f32x4*)(out + off + bj * HALF + n * 16) = bad1 ? (f32x4){qnan, qnan, qnan, qnan} : x1;
                        const f32x4 o = (x1 - sr.x) * sr.y; u32x2v w; w.x = cvt_pk_bf16(o[0], o[1]); w.y = cvt_pk_bf16(o[2], o[3]);
                        if (bad) { w.x = 0x7fc07fc0u; w.y = 0x7fc07fc0u; } *(u32x2v*)(xn + off + bj * HALF + n * 16) = w; }
                asm volatile("" ::: "memory"); }
    }
};

template <class Epi, class Sched, bool ALIGN_EPI = false, bool SP2 = false>
__device__ __forceinline__ void gemm_phase(PG8_LAS unsigned char* lds, const Gemm g, const Sched& S, const Epi& E) {
    const int tid = threadIdx.x, wid = __builtin_amdgcn_readfirstlane(tid >> 6), lane = tid & 63, wr = wid >> 2, wc = wid & 3, fr = lane & 15, fq = lane >> 4;
    const int K = g.K, nt = K / BK;
    unsigned voffA[2], voffB[2];
#pragma unroll
    for (int i = 0; i < 2; ++i) { int R, C; stage_rc(tid * 16 + i * 8192, R, C); const int Rb = Epi::PERM ? ((R & ~31) + perm32(R & 31)) : R;
        voffA[i] = (unsigned)(R * K + C) * 2u; voffB[i] = (unsigned)(Rb * K + C) * 2u; }
    const size_t kstep = (size_t)(BK * 2);
    const size_t hstep = (size_t)HALF * K * 2;
    const size_t tstep = 2 * hstep;
    const unsigned ldsw = (unsigned)wid * 1024u;
    const int aoff = lds_byte(wr * 64 + fr, fq * 8), boff = lds_byte(wc * 32 + fr, fq * 8);
#define PG8_SA(b, h) (((b) * 2 + (h)) * HTB)
#define PG8_SB(b, h) ((4 + (b) * 2 + (h)) * HTB)
#define PG8_STAGE(bufoff, gbase, voff) do { _Pragma("unroll") for (int _i = 0; _i < 2; ++_i) \
        __builtin_amdgcn_global_load_lds((const unsigned*)((const char*)(gbase) + (voff)[_i]), (PG8_LAS unsigned*)(lds + (bufoff) + ldsw + _i * 8192), 16, 0, 0); } while (0)
#define PG8_LDA(dst, b, h) do { _Pragma("unroll") for (int m = 0; m < 4; ++m) _Pragma("unroll") for (int k = 0; k < 2; ++k) dst[m][k] = *(const PG8_LAS bf16x8*)(lds + PG8_SA(b, h) + aoff + m * 2048 + k * 1024); } while (0)
#define PG8_LDB(dst, b, h) do { _Pragma("unroll") for (int n = 0; n < 2; ++n) _Pragma("unroll") for (int k = 0; k < 2; ++k) dst[n][k] = *(const PG8_LAS bf16x8*)(lds + PG8_SB(b, h) + boff + n * 2048 + k * 1024); } while (0)
#define PG8_MMA(ai, bj, At, Bt) do { __builtin_amdgcn_s_setprio(1); _Pragma("unroll") for (int m = 0; m < 4; ++m) _Pragma("unroll") for (int n = 0; n < 2; ++n) _Pragma("unroll") for (int k = 0; k < 2; ++k) \
        acc[ai][bj][m][n] = __builtin_amdgcn_mfma_f32_16x16x32_bf16(Bt[n][k], At[m][k], acc[ai][bj][m][n], 0, 0, 0); __builtin_amdgcn_s_setprio(0); } while (0)
#define PG8_WAIT_V(n) asm volatile("s_waitcnt vmcnt(" #n ")" ::: "memory")
#define PG8_WAIT_L(n) asm volatile("s_waitcnt lgkmcnt(" #n ")" ::: "memory")
#define PG8_BAR __builtin_amdgcn_s_barrier()
#define PG8_SCHED __builtin_amdgcn_sched_barrier(0)
    Unit cur, nxt; int ui = 0;
    if (!S.next(0, cur)) return;
    f32x4 acc[2][2][4][2];
#pragma unroll
    for (int a = 0; a < 2; ++a)
#pragma unroll
        for (int b = 0; b < 2; ++b)
#pragma unroll
            for (int m = 0; m < 4; ++m)
#pragma unroll
                for (int n = 0; n < 2; ++n) acc[a][b][m][n] = (f32x4){0.f, 0.f, 0.f, 0.f};
    bf16x8 At[4][2], B0[2][2], B1[2][2];
    const char* cA = (const char*)g.A + (size_t)cur.pm * tstep; const char* cB = (const char*)g.Bt + (size_t)cur.pn * tstep;
    S.a_ready(cur);
    if constexpr (SP2) {
        PG8_STAGE(PG8_SB(0, 0), cB, voffB); PG8_STAGE(PG8_SB(0, 1), cB + hstep, voffB); PG8_STAGE(PG8_SA(0, 0), cA, voffA); PG8_STAGE(PG8_SA(0, 1), cA + hstep, voffA);
        if (wr == 1) PG8_BAR;
        PG8_WAIT_V(2); PG8_BAR;
        PG8_STAGE(PG8_SB(1, 0), cB + kstep, voffB); PG8_STAGE(PG8_SA(1, 0), cA + kstep, voffA); PG8_STAGE(PG8_SB(1, 1), cB + hstep + kstep, voffB);
        PG8_WAIT_V(6); PG8_BAR;
    } else {
        PG8_STAGE(PG8_SB(0, 0), cB, voffB); PG8_STAGE(PG8_SA(0, 0), cA, voffA); PG8_STAGE(PG8_SB(0, 1), cB + hstep, voffB); PG8_STAGE(PG8_SA(0, 1), cA + hstep, voffA);
        if (wr == 1) PG8_BAR;
        PG8_WAIT_V(4); PG8_BAR;
        PG8_STAGE(PG8_SB(1, 0), cB + kstep, voffB); PG8_STAGE(PG8_SA(1, 0), cA + kstep, voffA); PG8_STAGE(PG8_SB(1, 1), cB + hstep + kstep, voffB);
        PG8_WAIT_V(6); PG8_BAR;
    }
    for (;;) {
        const bool has_next = S.next(ui + 1, nxt);
        const char* nA = has_next ? (const char*)g.A + (size_t)nxt.pm * tstep : cA; const char* nB = has_next ? (const char*)g.Bt + (size_t)nxt.pn * tstep : cB;
        for (int t = 0; t < nt; t += 2) {
            const bool last = (t == nt - 2);
            const char* a1 = cA + (size_t)(t + 1) * kstep;
            const char* a2 = last ? nA : cA + (size_t)(t + 2) * kstep; const char* b2 = last ? nB : cB + (size_t)(t + 2) * kstep;
            const char* a3 = a2 + kstep; const char* b3 = b2 + kstep;
            if (last && has_next) S.a_ready(nxt);
            if constexpr (SP2) {
            PG8_LDB(B0, 0, 0); PG8_LDB(B1, 0, 1); PG8_SCHED; PG8_LDA(At, 0, 0); PG8_STAGE(PG8_SA(1, 1), a1 + hstep, voffA);
            PG8_WAIT_V(8); PG8_WAIT_L(0); PG8_BAR; PG8_MMA(0, 0, At, B0); PG8_MMA(0, 1, At, B1); PG8_BAR; PG8_SCHED;
            PG8_LDA(At, 0, 1); PG8_STAGE(PG8_SB(0, 0), b2, voffB); PG8_STAGE(PG8_SB(0, 1), b2 + hstep, voffB); PG8_STAGE(PG8_SA(0, 0), a2, voffA);
            PG8_WAIT_V(8); PG8_WAIT_L(0); PG8_BAR; PG8_MMA(1, 0, At, B0); PG8_MMA(1, 1, At, B1); PG8_BAR; PG8_SCHED;
            PG8_LDB(B0, 1, 0); PG8_LDB(B1, 1, 1); PG8_SCHED; PG8_LDA(At, 1, 0); PG8_STAGE(PG8_SA(0, 1), a2 + hstep, voffA);
            PG8_WAIT_V(8); PG8_WAIT_L(0); PG8_BAR; PG8_MMA(0, 0, At, B0); PG8_MMA(0, 1, At, B1); PG8_BAR; PG8_SCHED;
            PG8_LDA(At, 1, 1); PG8_STAGE(PG8_SB(1, 0), b3, voffB); PG8_STAGE(PG8_SB(1, 1), b3 + hstep, voffB); PG8_STAGE(PG8_SA(1, 0), a3, voffA);
            PG8_WAIT_V(8); PG8_WAIT_L(0); PG8_BAR; PG8_MMA(1, 0, At, B0); PG8_MMA(1, 1, At, B1); PG8_BAR; PG8_SCHED;
            } else {
            PG8_LDB(B0, 0, 0); PG8_SCHED; PG8_LDA(At, 0, 0); PG8_STAGE(PG8_SA(1, 1), a1 + hstep, voffA);
            PG8_WAIT_L(8); PG8_BAR; PG8_WAIT_L(0); PG8_MMA(0, 0, At, B0); PG8_BAR; PG8_SCHED;
            PG8_LDB(B1, 0, 1); PG8_STAGE(PG8_SB(0, 0), b2, voffB);
            PG8_BAR; PG8_WAIT_L(0); PG8_MMA(0, 1, At, B1); PG8_BAR;
            PG8_LDA(At, 0, 1); PG8_STAGE(PG8_SA(0, 0), a2, voffA);
            PG8_BAR; PG8_WAIT_L(0); PG8_MMA(1, 0, At, B0); PG8_BAR; PG8_SCHED;
            PG8_STAGE(PG8_SB(0, 1), b2 + hstep, voffB);
            PG8_WAIT_V(6); PG8_BAR; PG8_MMA(1, 1, At, B1); PG8_BAR;
            PG8_LDB(B0, 1, 0); PG8_SCHED; PG8_LDA(At, 1, 0); PG8_STAGE(PG8_SA(0, 1), a2 + hstep, voffA);
            PG8_WAIT_L(8); PG8_BAR; PG8_WAIT_L(0); PG8_MMA(0, 0, At, B0); PG8_BAR; PG8_SCHED;
            PG8_LDB(B1, 1, 1); PG8_STAGE(PG8_SB(1, 0), b3, voffB);
            PG8_BAR; PG8_WAIT_L(0); PG8_MMA(0, 1, At, B1); PG8_BAR;
            PG8_LDA(At, 1, 1); PG8_STAGE(PG8_SA(1, 0), a3, voffA);
            PG8_BAR; PG8_WAIT_L(0); PG8_MMA(1, 0, At, B0); PG8_BAR; PG8_SCHED;
            PG8_STAGE(PG8_SB(1, 1), b3 + hstep, voffB);
            PG8_WAIT_V(6); PG8_BAR; PG8_MMA(1, 1, At, B1); PG8_BAR;
            }
        }
        if constexpr (ALIGN_EPI) { if (wr == 0) PG8_BAR; }
        if constexpr (!Epi::AFTER_DRAIN) { E(acc, cur, wr, wc, fr, fq); S.done(cur); }
        if (!has_next) break;
#pragma unroll
        for (int a = 0; a < 2; ++a)
#pragma unroll
            for (int b = 0; b < 2; ++b)
#pragma unroll
                for (int m = 0; m < 4; ++m)
#pragma unroll
                    for (int n = 0; n < 2; ++n) acc[a][b][m][n] = (f32x4){0.f, 0.f, 0.f, 0.f};
        cur = nxt; cA = nA; cB = nB; ++ui;
        if constexpr (ALIGN_EPI) { if (wr == 1) PG8_BAR; }
    }
    PG8_WAIT_V(0);
    if constexpr (!ALIGN_EPI) { if (wr == 0) PG8_BAR; }
    PG8_BAR;
    if constexpr (Epi::AFTER_DRAIN) { E.fused(acc, cur, wr, wc, fr, fq, lds, wid, lane); S.done(cur); }
#undef PG8_SA
#undef PG8_SB
#undef PG8_STAGE
#undef PG8_LDA
#undef PG8_LDB
#undef PG8_MMA
#undef PG8_WAIT_V
#undef PG8_WAIT_L
#undef PG8_BAR
#undef PG8_SCHED
}
}
#define LAS __attribute__((address_space(3)))
#define GAS __attribute__((address_space(1)))
#define XB_TMO      128
#define XB_XCNT(j)  (256  + 64 * (j))
#define XB_XSUB(j)  (1280 + 64 * (j))
#define XB_XGEN(j)  (2304 + 64 * (j))
#define XB_TOP      3328
#define XB_TOPGEN   3392
#define XCD_BAR_WORDS 3456
#define XB_SPIN_CAP (1u << 18)
typedef unsigned short bf16;
typedef unsigned v4u __attribute__((ext_vector_type(4)));
typedef unsigned v2u __attribute__((ext_vector_type(2)));
typedef float f32x4 __attribute__((ext_vector_type(4)));
typedef float f32x16 __attribute__((ext_vector_type(16)));
typedef short bf16x8 __attribute__((ext_vector_type(8)));

constexpr int NWAVES = 8, NTHR = 512;
constexpr int D = 1024, BATCH = 8, SEQ = 2048, M = BATCH * SEQ;
constexpr int CONVW = 512, GK = 256, NH = 4, DK = 64, DV = 128, RANK = 16;
constexpr int INC = 3088, NPROJ = 3072;
constexpr int PH = 8, NKEYS = 128, TOPK = 16, NQ = 2048;
constexpr float LN_EPS = 1e-5f, RMS_EPS = 1e-6f;
constexpr float ALPHA = 1.189207115002721f;
constexpr size_t MiB = 1u << 20;
constexpr size_t WS_CTL = 0, CTL_ZERO_BYTES = 1 * MiB;
constexpr size_t WS_MOD = 1 * MiB;
constexpr size_t WS_WIN = 2 * MiB;
constexpr size_t WS_WGLR = 8 * MiB;
constexpr size_t WS_WOUT = 9 * MiB;
constexpr size_t WS_WQ = 11 * MiB;
constexpr size_t WS_SUBK = 15 * MiB;
constexpr size_t WS_PU = 16 * MiB, WS_PV = 48 * MiB;
constexpr size_t WS_H = 80 * MiB;
constexpr size_t WS_PROJ = 112 * MiB;
constexpr size_t WS_X1 = 112 * MiB;
constexpr size_t WS_H2 = 176 * MiB;
constexpr size_t WS_GLR = 208 * MiB;
constexpr size_t WS_IDX = 209 * MiB, WS_GATE = 217 * MiB;
constexpr int CW_BAR = 4096;

constexpr int RING_BYTES = 131072, LDSCTL_OFF = RING_BYTES, MISC_OFF = LDSCTL_OFF + 320, LDS_BYTES = 147456;

__device__ __forceinline__ unsigned f2bf(float f) { unsigned u = __builtin_bit_cast(unsigned, f); return (u + 0x7fffu + ((u >> 16) & 1u)) >> 16; }
__device__ __forceinline__ unsigned pk2(float lo, float hi) { return f2bf(lo) | (f2bf(hi) << 16); }
__device__ __forceinline__ float bflo(unsigned w) { return __builtin_bit_cast(float, w << 16); }
__device__ __forceinline__ float bfhi(unsigned w) { return __builtin_bit_cast(float, w & 0xffff0000u); }
__device__ __forceinline__ float bf2f(bf16 v) { return __builtin_bit_cast(float, (unsigned)v << 16); }
__device__ __forceinline__ float silu_f(float v) { return v / (1.f + __expf(-v)); }
__device__ __forceinline__ float gelu_f(float v) { return 0.5f * v * (1.f + erff(v * 0.70710678118654752f)); }
__device__ __forceinline__ float logsig_f(float z) { return fminf(z, 0.f) - log1pf(__expf(-fabsf(z))); }
__device__ __forceinline__ float wave_sum(float v) {
#pragma unroll
    for (int o = 1; o < 64; o <<= 1) v += __shfl_xor(v, o);
    return v;
}
#define LDS_WAIT() asm volatile("s_waitcnt lgkmcnt(0)" ::: "memory")


__device__ __forceinline__ unsigned xb_ld(unsigned* p)              { return __hip_atomic_load(p, __ATOMIC_RELAXED, __HIP_MEMORY_SCOPE_AGENT); }
__device__ __forceinline__ unsigned xb_add(unsigned* p, unsigned v) { return __hip_atomic_fetch_add(p, v, __ATOMIC_RELAXED, __HIP_MEMORY_SCOPE_AGENT); }
__device__ __forceinline__ unsigned xb_xcc_id() { return (unsigned)__builtin_amdgcn_s_getreg((3 << 11) | 20) & 0xFu; }
#define XB_SPIN(cond, bar) do { unsigned _sp = 0; while (cond) { __builtin_amdgcn_s_sleep(1); \
    if ((++_sp & 255u) == 0u) { if (xb_ld(&(bar)[XB_TMO])) break; if (_sp > XB_SPIN_CAP) { atomicAdd(&(bar)[XB_TMO], 1u); break; } } } } while (0)

struct XcdBarrier {
    unsigned* bar; unsigned x;
    volatile LAS unsigned* st;
};

__device__ __forceinline__ XcdBarrier xcd_barrier_post(unsigned* bar, volatile LAS unsigned* st) {
    XcdBarrier b; b.bar = bar; b.x = xb_xcc_id(); b.st = st;
    if (threadIdx.x == 0) (void)xb_add(&bar[XB_XCNT(b.x)], 1u);
    return b;
}
__device__ __forceinline__ void xcd_barrier_complete(unsigned* bar, unsigned x, unsigned& nloc, unsigned& nx) {
    const unsigned G = gridDim.x * gridDim.y * gridDim.z;
    unsigned sum, cnt, mine, sp = 0u;
    for (;;) {
        sum = 0u; cnt = 0u; mine = 0u;
#pragma unroll
        for (unsigned j = 0; j < 16; ++j) { const unsigned c = xb_ld(&bar[XB_XCNT(j)]); sum += c; cnt += (c > 0u) ? 1u : 0u; mine = (j == x) ? c : mine; }
        if (sum == G) break;
        __builtin_amdgcn_s_sleep(1);
        if ((++sp & 255u) == 0u) { if (xb_ld(&bar[XB_TMO])) break; if (sp > XB_SPIN_CAP) { atomicAdd(&bar[XB_TMO], 1u); break; } }
    }
    nloc = mine > 0u ? mine : 1u; nx = cnt > 0u ? cnt : 1u;
}

__device__ __forceinline__ void xcd_barrier(const XcdBarrier& b) {
    asm volatile("s_waitcnt vmcnt(0)" ::: "memory");
    __syncthreads();
    if (threadIdx.x == 0) {
        unsigned* bar = b.bar;
        __builtin_amdgcn_s_waitcnt(0);
        unsigned nloc = b.st[0], nx = b.st[1];
        if (nloc == 0u) { xcd_barrier_complete(bar, b.x, nloc, nx); b.st[0] = nloc; b.st[1] = nx; }
        const unsigned old = xb_add(&bar[XB_XSUB(b.x)], 1u);
        const unsigned gen = old / nloc;
        if (old + 1u == (gen + 1u) * nloc) {
            __builtin_amdgcn_fence(__ATOMIC_RELEASE, "agent");
            asm volatile("s_waitcnt vmcnt(0)" ::: "memory");
            const unsigned og = xb_add(&bar[XB_TOP], 1u);
            const unsigned tg = og / nx;
            if (og + 1u == (tg + 1u) * nx) xb_add(&bar[XB_TOPGEN], 1u);
            else XB_SPIN(xb_ld(&bar[XB_TOPGEN]) == tg, bar);
            __builtin_amdgcn_fence(__ATOMIC_ACQUIRE, "agent");
            xb_add(&bar[XB_XGEN(b.x)], 1u);
            asm volatile("s_waitcnt vmcnt(0)" ::: "memory");
        } else {
            XB_SPIN(xb_ld(&bar[XB_XGEN(b.x)]) == gen, bar);
            __builtin_amdgcn_fence(__ATOMIC_ACQUIRE, "agent");
            asm volatile("s_waitcnt vmcnt(0)" ::: "memory");
        }
    }
    __syncthreads();
}


constexpr int ARGT_OFF = LDSCTL_OFF + 1024;
enum ArgIdx { A_X = 0, A_C, A_WMOD, A_BMOD, A_WIN, A_CONVW, A_GATEUP, A_GATEBIAS, A_NORMG, A_WOUT, A_LN1G, A_LN1B, A_WQ, A_SUBK, A_PU, A_PV, A_LN2G, A_LN2B, A_OUT, A_WS, A_COUNT };
struct Ctx { LAS unsigned char* lds; int tid, lane, wave, wg, G, gw, NGW; };
__device__ __forceinline__ unsigned long long ldarg(const Ctx& C, int i) {
    volatile LAS unsigned* p = (volatile LAS unsigned*)(C.lds + ARGT_OFF) + 2 * i;
    const unsigned lo = __builtin_amdgcn_readfirstlane(p[0]), hi = __builtin_amdgcn_readfirstlane(p[1]);
    return ((unsigned long long)hi << 32) | lo;
}
#define ARGF(i) ((const float*)ldarg(C, (i)))
#define ARG_WS ((unsigned char*)ldarg(C, A_WS))
#define ARG_OUT ((float*)ldarg(C, A_OUT))

__device__ __forceinline__ void p0_mod_item(const Ctx& C, int item) {
    LAS float* sc = (LAS float*)C.lds; LAS float* red = sc + BATCH * D;
    float* mod = (float*)(ARG_WS + WS_MOD); const float* c_in = ARGF(A_C); const float* w_mod = ARGF(A_WMOD); const float* b_mod = ARGF(A_BMOD);
    for (int i = C.tid; i < BATCH * D; i += NTHR) sc[i] = silu_f(c_in[i]);
    __syncthreads();
    const int col = C.lane & 31, kp = C.lane >> 5, n0 = item * 32;
    float acc[BATCH];
#pragma unroll
    for (int b = 0; b < BATCH; ++b) acc[b] = 0.f;
    for (int i = 0; i < 64; ++i) {
        const int k = 128 * C.wave + 2 * i + kp; const float wv = w_mod[(size_t)k * (6 * D) + n0 + col];
#pragma unroll
        for (int b = 0; b < BATCH; ++b) acc[b] += sc[b * D + k] * wv;
    }
#pragma unroll
    for (int b = 0; b < BATCH; ++b) acc[b] += __shfl_xor(acc[b], 32);
    if (C.lane < 32) {
#pragma unroll
        for (int b = 0; b < BATCH; ++b) red[(C.wave * 8 + b) * 32 + col] = acc[b];
    }
    __syncthreads();
    if (C.tid < 256) { const int b = C.tid >> 5, cc = C.tid & 31; float s = b_mod[n0 + cc];
#pragma unroll
        for (int w = 0; w < 8; ++w) s += red[(w * 8 + b) * 32 + cc];
        mod[b * (6 * D) + n0 + cc] = s; }
    __syncthreads();
}
__device__ __forceinline__ void p0_transpose_item(const float* W, int ldw, int K, int k0, int n0, bf16* WT, LAS float* scr, int lane) {
#pragma unroll 8
    for (int i = 0; i < 32; ++i) { const int kk = 2 * i + (lane >> 5); scr[kk * 33 + (lane & 31)] = W[(size_t)(k0 + kk) * ldw + n0 + (lane & 31)]; }
    LDS_WAIT(); asm volatile("" ::: "memory");
    const int c = lane & 7;
#pragma unroll
    for (int j = 0; j < 4; ++j) { const int n = (lane >> 3) + 8 * j; const LAS float* s = scr + (8 * c) * 33 + n;
        v4u o; o.x = pk2(s[0 * 33], s[1 * 33]); o.y = pk2(s[2 * 33], s[3 * 33]); o.z = pk2(s[4 * 33], s[5 * 33]); o.w = pk2(s[6 * 33], s[7 * 33]);
        *(v4u*)(WT + (size_t)(n0 + n) * K + k0 + 8 * c) = o; }
    LDS_WAIT(); asm volatile("" ::: "memory");
}
__device__ __forceinline__ void p0_cvt_item(const float* src, bf16* dst, size_t item, int lane) {
#pragma unroll
    for (int r = 0; r < 4; ++r) { const size_t off = item * 2048 + r * 512 + lane * 8; const f32x4 a = *(const f32x4*)(src + off), b = *(const f32x4*)(src + off + 4);
        v4u o; o.x = pk2(a.x, a.y); o.y = pk2(a.z, a.w); o.z = pk2(b.x, b.y); o.w = pk2(b.z, b.w); *(v4u*)(dst + off) = o; }
}
__device__ __forceinline__ void phase0(const Ctx& C) {
    if (C.wg < 192) p0_mod_item(C, C.wg);
    LAS float* scr = (LAS float*)(C.lds + C.wave * 16384);
    unsigned char* ws = ARG_WS; const float* w_in = ARGF(A_WIN); const float* w_out = ARGF(A_WOUT); const float* wq = ARGF(A_WQ); const float* pu = ARGF(A_PU); const float* pv = ARGF(A_PV); const float* subkeys = ARGF(A_SUBK);
    bf16* WIN = (bf16*)(ws + WS_WIN); bf16* WOUT = (bf16*)(ws + WS_WOUT); bf16* WQ = (bf16*)(ws + WS_WQ); bf16* WGLR = (bf16*)(ws + WS_WGLR);
    bf16* PU = (bf16*)(ws + WS_PU); bf16* PV = (bf16*)(ws + WS_PV); bf16* SUBK = (bf16*)(ws + WS_SUBK);
    constexpr int I_IN = 16 * 96, I_OUT = 16 * 32, I_Q = 16 * 64, I_U = 8192, I_S = 128;
    constexpr int NITEMS = I_IN + I_OUT + I_Q + 2 * I_U + I_S;
    for (int it = C.gw; it < NITEMS; it += C.NGW) {
        int r = it;
        if (r < I_IN) { p0_transpose_item(w_in, INC, D, 64 * (r / 96), 32 * (r % 96), WIN, scr, C.lane); continue; } r -= I_IN;
        if (r < I_OUT) { p0_transpose_item(w_out, D, D, 64 * (r / 32), 32 * (r % 32), WOUT, scr, C.lane); continue; } r -= I_OUT;
        if (r < I_Q) { p0_transpose_item(wq, NQ, D, 64 * (r / 64), 32 * (r % 64), WQ, scr, C.lane); continue; } r -= I_Q;
        if (r < I_U) { p0_cvt_item(pu, PU, (size_t)r, C.lane); continue; } r -= I_U;
        if (r < I_U) { p0_cvt_item(pv, PV, (size_t)r, C.lane); continue; } r -= I_U;
        p0_cvt_item(subkeys, SUBK, (size_t)r, C.lane);
    }
    for (int i = C.gw * 64 + C.lane; i < RANK * D; i += C.NGW * 64) { const int j = i >> 10, k = i & 1023; WGLR[i] = (bf16)f2bf(w_in[(size_t)k * INC + NPROJ + j]); }
}
__device__ __forceinline__ void phase0b(const Ctx& C) {
    unsigned char* ws = ARG_WS; const float* x = ARGF(A_X);
    const float* mod = (const float*)(ws + WS_MOD); bf16* H = (bf16*)(ws + WS_H);
    for (int m = C.gw; m < M; m += C.NGW) {
        const int b = m / SEQ; const f32x4* sh = (const f32x4*)(mod + b * 6 * D) + C.lane; const f32x4* sc = (const f32x4*)(mod + b * 6 * D + D) + C.lane;
        const f32x4* xr = (const f32x4*)(x + (size_t)m * D) + C.lane;
        unsigned long long* o8 = (unsigned long long*)(H + (size_t)m * D) + C.lane;
#pragma unroll
        for (int j = 0; j < 4; ++j) { const f32x4 v = xr[64 * j] * (sc[64 * j] + 1.0f) + sh[64 * j]; o8[64 * j] = (unsigned long long)pk2(v.x, v.y) | ((unsigned long long)pk2(v.z, v.w) << 32); }
    }
}
struct EpiF32 {
    static constexpr bool PERM = false, AFTER_DRAIN = false;
    float* O; int ldc;
    __device__ __forceinline__ void operator()(const pg8::f32x4 (&acc)[2][2][4][2], const pg8::Unit& u, int wr, int wc, int fr, int fq) const {
        const int col0 = u.pn * 256 + wc * 32 + 4 * fq;
#pragma unroll
        for (int ai = 0; ai < 2; ++ai)
#pragma unroll
            for (int m = 0; m < 4; ++m) { float* rowp = O + (size_t)(u.pm * 256 + ai * 128 + wr * 64 + m * 16 + fr) * ldc + col0;
#pragma unroll
                for (int bj = 0; bj < 2; ++bj)
#pragma unroll
                    for (int n = 0; n < 2; ++n) *(pg8::f32x4*)(rowp + bj * 128 + n * 16) = acc[ai][bj][m][n]; }
    }
};
__device__ __forceinline__ void glr_simple(const Ctx& C) {
    unsigned char* ws = ARG_WS;
    const bf16* H = (const bf16*)(ws + WS_H); const bf16* WGLR = (const bf16*)(ws + WS_WGLR); float* GLR = (float*)(ws + WS_GLR);
    for (int i = C.gw * 64 + C.lane; i < M * RANK; i += C.NGW * 64) {
        const int m = i >> 4, j = i & 15; const v4u* hr = (const v4u*)(H + (size_t)m * D); const v4u* wr = (const v4u*)(WGLR + (size_t)j * D);
        float acc = 0.f;
        for (int kc = 0; kc < 128; ++kc) { const v4u a = hr[kc], w = wr[kc];
            acc += bflo(a.x) * bflo(w.x) + bfhi(a.x) * bfhi(w.x) + bflo(a.y) * bflo(w.y) + bfhi(a.y) * bfhi(w.y) + bflo(a.z) * bflo(w.z) + bfhi(a.z) * bfhi(w.z) + bflo(a.w) * bflo(w.w) + bfhi(a.w) * bfhi(w.w); }
        GLR[i] = acc;
    }
}
__device__ __forceinline__ void conv_phase(const Ctx& C) {
    unsigned char* ws = ARG_WS; const float* conv_w = ARGF(A_CONVW);
    const bf16* PROJ = (const bf16*)(ws + WS_PROJ); bf16* YMIX = (bf16*)(ws + WS_H);
    for (int i = C.gw * 64 + C.lane; i < M * 64; i += C.NGW * 64) {
        const int m = i >> 6, c = (i & 63) * 8, s = m % SEQ;
        float z[8];
#pragma unroll
        for (int k = 0; k < 8; ++k) z[k] = 0.f;
#pragma unroll
        for (int j = 0; j < 3; ++j) { const int sp = s - 2 + j;
            if (sp >= 0) { const bf16* row = PROJ + (size_t)(m - 2 + j) * NPROJ; const v4u cc = *(const v4u*)(row + CONVW + c), ch = *(const v4u*)(row + 2 * CONVW + c);
                const f32x4 w0 = *(const f32x4*)(conv_w + j * CONVW + c), w1 = *(const f32x4*)(conv_w + j * CONVW + c + 4);
                z[0] += w0.x * bflo(cc.x) * bflo(ch.x); z[1] += w0.y * bfhi(cc.x) * bfhi(ch.x); z[2] += w0.z * bflo(cc.y) * bflo(ch.y); z[3] += w0.w * bfhi(cc.y) * bfhi(ch.y);
                z[4] += w1.x * bflo(cc.z) * bflo(ch.z); z[5] += w1.y * bfhi(cc.z) * bfhi(ch.z); z[6] += w1.z * bflo(cc.w) * bflo(ch.w); z[7] += w1.w * bfhi(cc.w) * bfhi(ch.w); } }
        const v4u cb = *(const v4u*)(PROJ + (size_t)m * NPROJ + c);
        v4u o; o.x = pk2(bflo(cb.x) * z[0], bfhi(cb.x) * z[1]); o.y = pk2(bflo(cb.y) * z[2], bfhi(cb.y) * z[3]); o.z = pk2(bflo(cb.z) * z[4], bfhi(cb.z) * z[5]); o.w = pk2(bflo(cb.w) * z[6], bfhi(cb.w) * z[7]);
        *(v4u*)(YMIX + (size_t)m * D + c) = o;
    }
}
__device__ __forceinline__ void gla_recurrent(const Ctx& C, int bh) {
    const int b = bh >> 2, h = bh & 3, e = C.tid & 127, dq = C.tid >> 7;
    unsigned char* ws = ARG_WS; const float* gate_up = ARGF(A_GATEUP); const float* gate_bias = ARGF(A_GATEBIAS); const float* norm_g = ARGF(A_NORMG);
    const bf16* PROJ = (const bf16*)(ws + WS_PROJ); bf16* YMIX = (bf16*)(ws + WS_H); const float* GLR = (const float*)(ws + WS_GLR);
    LAS float* sq = (LAS float*)C.lds; LAS float* sk = sq + 64; LAS float* sg = sk + 64; LAS float* po = sg + 64; LAS float* red = po + 512;
    float S[16];
#pragma unroll
    for (int i = 0; i < 16; ++i) S[i] = 0.f;
    float gu[RANK]; float bias = 0.f;
#pragma unroll
    for (int j = 0; j < RANK; ++j) gu[j] = 0.f;
    if (C.tid < 64) { bias = gate_bias[h * DK + C.tid];
#pragma unroll
        for (int j = 0; j < RANK; ++j) gu[j] = gate_up[j * GK + h * DK + C.tid]; }
    const float ng = norm_g[h * DV + e];
    for (int t = 0; t < SEQ; ++t) {
        const size_t m = (size_t)b * SEQ + t; const bf16* row = PROJ + m * NPROJ;
        if (C.tid < 64) { float z = bias;
#pragma unroll
            for (int j = 0; j < RANK; ++j) z += GLR[m * RANK + j] * gu[j];
            sg[C.tid] = __expf(logsig_f(z) * (1.f / 16.f)); sq[C.tid] = bf2f(row[1536 + h * DK + C.tid]) * 0.125f; sk[C.tid] = bf2f(row[1792 + h * DK + C.tid]); }
        const float v = bf2f(row[2048 + h * DV + e]);
        __syncthreads();
        float o = 0.f;
#pragma unroll
        for (int i = 0; i < 16; ++i) { const int d = 16 * dq + i; S[i] = sg[d] * S[i] + sk[d] * v; o += sq[d] * S[i]; }
        po[dq * 128 + e] = o;
        __syncthreads();
        float ot = 0.f;
        if (C.tid < 128) { ot = po[e] + po[128 + e] + po[256 + e] + po[384 + e]; const float ss = wave_sum(ot * ot); if (C.lane == 0) red[C.wave] = ss; }
        __syncthreads();
        if (C.tid < 128) { const float ms = (red[0] + red[1]) * (1.f / DV); const float r = bf2f(row[2560 + h * DV + e]);
            YMIX[m * D + CONVW + h * DV + e] = (bf16)f2bf(ot * rsqrtf(ms + RMS_EPS) * ng * silu_f(r)); }
    }
    __syncthreads();
}
__device__ __forceinline__ void ln1_phase(const Ctx& C) {
    unsigned char* ws = ARG_WS; const float* x = ARGF(A_X); const float* ln1_g = ARGF(A_LN1G); const float* ln1_b = ARGF(A_LN1B);
    const float* mod = (const float*)(ws + WS_MOD); const float* Y = ARG_OUT; float* X1 = (float*)(ws + WS_X1); bf16* H2 = (bf16*)(ws + WS_H2);
    for (int m = C.gw; m < M; m += C.NGW) {
        const int b = m / SEQ; const float* mrow = mod + b * 6 * D;
        const f32x4* g1 = (const f32x4*)(mrow + 2 * D) + C.lane; const f32x4* sh2 = (const f32x4*)(mrow + 3 * D) + C.lane; const f32x4* sc2 = (const f32x4*)(mrow + 4 * D) + C.lane;
        const f32x4* xr = (const f32x4*)(x + (size_t)m * D) + C.lane; const f32x4* yr = (const f32x4*)(Y + (size_t)m * D) + C.lane;
        f32x4 v[4]; float s = 0.f;
#pragma unroll
        for (int j = 0; j < 4; ++j) { v[j] = xr[64 * j] * ALPHA + (g1[64 * j] + 1.0f) * yr[64 * j]; s += (v[j].x + v[j].y) + (v[j].z + v[j].w); }
        const float mean = wave_sum(s) * (1.f / D); float q = 0.f;
#pragma unroll
        for (int j = 0; j < 4; ++j) { v[j] = v[j] - mean; q += (v[j].x * v[j].x + v[j].y * v[j].y) + (v[j].z * v[j].z + v[j].w * v[j].w); }
        const float rstd = rsqrtf(wave_sum(q) * (1.f / D) + LN_EPS);
        f32x4* xo = (f32x4*)(X1 + (size_t)m * D) + C.lane; unsigned long long* ho = (unsigned long long*)(H2 + (size_t)m * D) + C.lane;
#pragma unroll
        for (int j = 0; j < 4; ++j) { const f32x4 x1 = v[j] * rstd * ((const f32x4*)ln1_g)[C.lane + 64 * j] + ((const f32x4*)ln1_b)[C.lane + 64 * j]; xo[64 * j] = x1;
            const f32x4 h2 = x1 * (sc2[64 * j] + 1.0f) + sh2[64 * j]; ho[64 * j] = (unsigned long long)pk2(h2.x, h2.y) | ((unsigned long long)pk2(h2.z, h2.w) << 32); }
    }
}
__device__ __forceinline__ int fkey(float f) { const int b = __builtin_bit_cast(int, f); return b ^ ((b >> 31) & 0x7fffffff); }
__device__ __forceinline__ float kfloat(int k) { const int b = k ^ ((k >> 31) & 0x7fffffff); return __builtin_bit_cast(float, b); }
template <int N> __device__ __forceinline__ void sort16_groups_desc(int (&v)[N]) {
#pragma unroll
    for (int ks = 1; ks <= 4; ++ks)
#pragma unroll
        for (int js = ks - 1; js >= 0; --js)
#pragma unroll
            for (int i = 0; i < N; ++i) { const int k = 1 << ks, j = 1 << js, l = i ^ j;
                if (l > i) { const bool desc = ((i & 15 & k) == 0); const int mx = max(v[i], v[l]), mn = min(v[i], v[l]); v[i] = desc ? mx : mn; v[l] = desc ? mn : mx; } }
}
template <int OA, int OB, int N> __device__ __forceinline__ void merge_top16(int (&v)[N]) {
#pragma unroll
    for (int i = 0; i < 16; ++i) v[OA + i] = max(v[OA + i], v[OB + 15 - i]);
#pragma unroll
    for (int js = 3; js >= 0; --js)
#pragma unroll
        for (int i = 0; i < 16; ++i) { const int j = 1 << js, l = i ^ j; if (l > i) { const int mx = max(v[OA + i], v[OA + l]), mn = min(v[OA + i], v[OA + l]); v[OA + i] = mx; v[OA + l] = mn; } }
}
__device__ __forceinline__ void top16_of_64(int (&v)[64]) { sort16_groups_desc<64>(v); merge_top16<0, 16, 64>(v); merge_top16<32, 48, 64>(v); merge_top16<0, 32, 64>(v); }
constexpr int cand_n(int a) { return a == 0 ? 16 : 16 / (a + 1); }
constexpr int cand_off(int a) { int s = 0; for (int i = 0; i < a; ++i) s += cand_n(i); return s; }
static_assert(cand_off(16) == 50, "staircase candidate count");

__device__ __forceinline__ void route_item(const bf16* Q, const bf16* SUBK, int* IDX, float* GATE, int tg, int h, LAS unsigned char* slot, int lane) {
    const int col = lane & 31, hi = lane >> 5, t = tg * 32 + col;
    LAS int* tl = (LAS int*)slot + lane;
#pragma unroll 1
    for (int p = 0; p < 2; ++p) {
        f32x16 acc[4];
#pragma unroll
        for (int kt = 0; kt < 4; ++kt)
#pragma unroll
            for (int r = 0; r < 16; ++r) acc[kt][r] = 0.f;
        const bf16* qrow = Q + (size_t)t * NQ + h * 256 + p * 128 + 8 * hi;
        const bf16* kb = SUBK + ((size_t)(h * 2 + p) * NKEYS + col) * 128 + 8 * hi;
#pragma unroll
        for (int ks = 0; ks < 8; ++ks) { const bf16x8 bq = *(const bf16x8*)(qrow + ks * 16);
#pragma unroll
            for (int kt = 0; kt < 4; ++kt) { const bf16x8 ak = *(const bf16x8*)(kb + (size_t)kt * 32 * 128 + ks * 16); acc[kt] = __builtin_amdgcn_mfma_f32_32x32x16_bf16(ak, bq, acc[kt], 0, 0, 0); } }
        int v[64];
#pragma unroll
        for (int kt = 0; kt < 4; ++kt)
#pragma unroll
            for (int r = 0; r < 16; ++r) { const int n = kt * 32 + 8 * (r >> 2) + (r & 3) + 4 * hi; v[kt * 16 + r] = (fkey(acc[kt][r]) & ~0x7F) | n; }
        top16_of_64(v);
#pragma unroll
        for (int i = 0; i < 16; ++i) v[16 + i] = __shfl_xor(v[i], 32);
        merge_top16<0, 16, 64>(v);
#pragma unroll
        for (int i = 0; i < 16; ++i) tl[(p * 16 + i) * 64] = v[i];
    }
    int c[64];
    {
        float s1[16], s2[16];
#pragma unroll
        for (int i = 0; i < 16; ++i) { s1[i] = kfloat(tl[i * 64] & ~0x7F); s2[i] = kfloat(tl[(16 + i) * 64] & ~0x7F); }
#pragma unroll
        for (int a = 0; a < 16; ++a)
#pragma unroll
            for (int b = 0; b < 16; ++b) if (b < cand_n(a)) c[cand_off(a) + b] = (fkey(s1[a] + s2[b]) & ~0xFF) | (a * 16 + b);
    }
#pragma unroll
    for (int i = 50; i < 64; ++i) c[i] = (int)0x80000000;
    top16_of_64(c);
    const float mx = kfloat(c[0] & ~0xFF);
    float ev[16]; float sum = 0.f; int id[16];
#pragma unroll
    for (int i = 0; i < 16; ++i) { ev[i] = __expf(kfloat(c[i] & ~0xFF) - mx); sum += ev[i]; const int ab = c[i] & 0xFF; id[i] = (tl[(ab >> 4) * 64] & 0x7F) * NKEYS + (tl[(16 + (ab & 15)) * 64] & 0x7F); }
    const float inv = 1.f / sum;
    if (hi == 0) { int* dst = IDX + ((size_t)t * PH + h) * TOPK;
#pragma unroll
        for (int q4 = 0; q4 < 4; ++q4) { v4u o; o.x = (unsigned)id[4 * q4]; o.y = (unsigned)id[4 * q4 + 1]; o.z = (unsigned)id[4 * q4 + 2]; o.w = (unsigned)id[4 * q4 + 3]; *(v4u*)(dst + 4 * q4) = o; }
    } else { float* dst = GATE + ((size_t)t * PH + h) * TOPK;
#pragma unroll
        for (int q4 = 0; q4 < 4; ++q4) { f32x4 o; o.x = ev[4 * q4] * inv; o.y = ev[4 * q4 + 1] * inv; o.z = ev[4 * q4 + 2] * inv; o.w = ev[4 * q4 + 3] * inv; *(f32x4*)(dst + 4 * q4) = o; }
    }
}
__device__ __forceinline__ void route_phase(const Ctx& C) {
    unsigned char* ws = ARG_WS;
    const bf16* Q = (const bf16*)ARG_OUT; const bf16* SUBK = (const bf16*)(ws + WS_SUBK); int* IDX = (int*)(ws + WS_IDX); float* GATE = (float*)(ws + WS_GATE);
    for (int item = C.gw; item < (M / 32) * PH; item += C.NGW) route_item(Q, SUBK, IDX, GATE, item >> 3, item & 7, C.lds + C.wave * 8192, C.lane);
}
__device__ __forceinline__ void unpack8(const v4u p, float* f) { f[0] = bflo(p.x); f[1] = bfhi(p.x); f[2] = bflo(p.y); f[3] = bfhi(p.y); f[4] = bflo(p.z); f[5] = bfhi(p.z); f[6] = bflo(p.w); f[7] = bfhi(p.w); }
#define PEER_GROUP(idreg, greg, jbase)                                                                                         \
    {                                                                                                                          \
        int e_[4]; float gg_[4]; v4u ua_[4], ub_[4];                                                                           \
        _Pragma("unroll") for (int i = 0; i < 4; ++i) { e_[i] = __builtin_amdgcn_readlane(idreg, (jbase) + i); gg_[i] = __builtin_bit_cast(float, __builtin_amdgcn_readlane(__builtin_bit_cast(int, greg), (jbase) + i)); } \
        _Pragma("unroll") for (int i = 0; i < 4; ++i) { const bf16* ur = PU + (size_t)e_[i] * D + lane * 8; ua_[i] = *(const v4u*)ur; ub_[i] = *(const v4u*)(ur + 512); }                                              \
        v4u va_[4], vb_[4];                                                                                                    \
        _Pragma("unroll") for (int i = 0; i < 4; ++i) { const bf16* vr = PV + (size_t)e_[i] * D + lane * 8; va_[i] = *(const v4u*)vr; vb_[i] = *(const v4u*)(vr + 512); }                                              \
        float dt_[4];                                                                                                          \
        _Pragma("unroll") for (int i = 0; i < 4; ++i) { float f_[16]; unpack8(ua_[i], f_); unpack8(ub_[i], f_ + 8); float s_ = 0.f;                                                                                    \
            _Pragma("unroll") for (int k = 0; k < 16; ++k) s_ += f_[k] * hv[k]; dt_[i] = s_; }                                 \
        _Pragma("unroll") for (int o = 1; o < 64; o <<= 1) { _Pragma("unroll") for (int i = 0; i < 4; ++i) dt_[i] += __shfl_xor(dt_[i], o); }                                                                          \
        _Pragma("unroll") for (int i = 0; i < 4; ++i) { const float a_ = gelu_f(dt_[i]) * gg_[i]; float f_[16]; unpack8(va_[i], f_); unpack8(vb_[i], f_ + 8);                                                         \
            _Pragma("unroll") for (int k = 0; k < 16; ++k) acc[k] += a_ * f_[k]; }                                             \
    }
__device__ __forceinline__ void peer_phase(const Ctx& C) {
    unsigned char* ws = ARG_WS; float* out = ARG_OUT; const float* ln2_g = ARGF(A_LN2G); const float* ln2_b = ARGF(A_LN2B);
    const float* mod = (const float*)(ws + WS_MOD); const bf16* H2 = (const bf16*)(ws + WS_H2); const bf16* PU = (const bf16*)(ws + WS_PU); const bf16* PV = (const bf16*)(ws + WS_PV);
    const int* IDX = (const int*)(ws + WS_IDX); const float* GATE = (const float*)(ws + WS_GATE); const float* X1 = (const float*)(ws + WS_X1);
    const int lane = C.lane;
    for (int t = C.gw; t < M; t += C.NGW) {
        const int b = t / SEQ; const float* mrow = mod + b * 6 * D;
        float hv[16];
        { const v4u p0 = *(const v4u*)(H2 + (size_t)t * D + lane * 8), p1 = *(const v4u*)(H2 + (size_t)t * D + 512 + lane * 8); unpack8(p0, hv); unpack8(p1, hv + 8); }
        const int id0 = IDX[(size_t)t * 128 + lane], id1 = IDX[(size_t)t * 128 + 64 + lane];
        const float g0 = GATE[(size_t)t * 128 + lane], g1 = GATE[(size_t)t * 128 + 64 + lane];
        float acc[16];
#pragma unroll
        for (int k = 0; k < 16; ++k) acc[k] = 0.f;
        for (int jb = 0; jb < 64; jb += 4) PEER_GROUP(id0, g0, jb)
        for (int jb = 0; jb < 64; jb += 4) PEER_GROUP(id1, g1, jb)
        float v[16]; float s = 0.f;
#pragma unroll
        for (int hb = 0; hb < 2; ++hb)
#pragma unroll
            for (int q4 = 0; q4 < 2; ++q4) { const int cidx = hb * 512 + lane * 8 + q4 * 4; const f32x4 xv = *(const f32x4*)(X1 + (size_t)t * D + cidx); const f32x4 g2 = *(const f32x4*)(mrow + 5 * D + cidx);
                const int k = hb * 8 + q4 * 4;
                v[k] = ALPHA * xv.x + (1.f + g2.x) * acc[k]; v[k + 1] = ALPHA * xv.y + (1.f + g2.y) * acc[k + 1]; v[k + 2] = ALPHA * xv.z + (1.f + g2.z) * acc[k + 2]; v[k + 3] = ALPHA * xv.w + (1.f + g2.w) * acc[k + 3];
                s += (v[k] + v[k + 1]) + (v[k + 2] + v[k + 3]); }
        const float mean = wave_sum(s) * (1.f / D); float q = 0.f;
#pragma unroll
        for (int k = 0; k < 16; ++k) { v[k] -= mean; q += v[k] * v[k]; }
        const float rstd = rsqrtf(wave_sum(q) * (1.f / D) + LN_EPS);
#pragma unroll
        for (int hb = 0; hb < 2; ++hb)
#pragma unroll
            for (int q4 = 0; q4 < 2; ++q4) { const int cidx = hb * 512 + lane * 8 + q4 * 4; const f32x4 gg = *(const f32x4*)(ln2_g + cidx), bb = *(const f32x4*)(ln2_b + cidx); const int k = hb * 8 + q4 * 4;
                f32x4 o; o.x = v[k] * rstd * gg.x + bb.x; o.y = v[k + 1] * rstd * gg.y + bb.y; o.z = v[k + 2] * rstd * gg.z + bb.z; o.w = v[k + 3] * rstd * gg.w + bb.w;
                *(f32x4*)(out + (size_t)t * D + cidx) = o; }
    }
}
#ifndef MK_N_LAUNCHES
#define MK_N_LAUNCHES 1
#endif
constexpr int NPH = 9;
constexpr int N_LAUNCHES = MK_N_LAUNCHES;
static_assert(N_LAUNCHES == 1 || N_LAUNCHES == NPH, "MK_N_LAUNCHES is 1 or NPH");

struct Args { const float* in[18]; float* out; unsigned char* ws; int ph_lo, ph_hi; };

__global__ void __launch_bounds__(NTHR, 2) mk_fwd(Args args) {
    extern __shared__ __attribute__((aligned(16))) unsigned char lds_raw[];
    Ctx C;
    C.lds = (LAS unsigned char*)lds_raw;
    C.tid = threadIdx.x; C.lane = C.tid & 63; C.wave = __builtin_amdgcn_readfirstlane(C.tid >> 6);
    C.wg = blockIdx.x; C.G = gridDim.x; C.gw = C.wg * NWAVES + C.wave; C.NGW = C.G * NWAVES;
    volatile LAS unsigned* MISC = (volatile LAS unsigned*)(C.lds + MISC_OFF);
    for (int u = C.tid; u < (LDS_BYTES - LDSCTL_OFF) / 4; u += NTHR) ((LAS unsigned*)(C.lds + LDSCTL_OFF))[u] = 0u;
    __syncthreads();
    if (C.tid < A_COUNT) {
        const unsigned long long v = (C.tid < 18) ? (unsigned long long)args.in[C.tid < 18 ? C.tid : 0] : (C.tid == A_OUT ? (unsigned long long)args.out : (unsigned long long)args.ws);
        ((LAS unsigned long long*)(C.lds + ARGT_OFF))[C.tid] = v;
    }
    __syncthreads();
    unsigned* ctl = (unsigned*)(ARG_WS + WS_CTL);
    XcdBarrier bar; bar.bar = ctl + CW_BAR; bar.x = 0; bar.st = nullptr;
    if (N_LAUNCHES == 1) bar = xcd_barrier_post(ctl + CW_BAR, MISC + 8);
    const int lo = args.ph_lo, hi = args.ph_hi;
#define IN(k) (lo <= (k) && (k) < hi)
#define SEAM(k) do { if (IN(k) && IN((k) + 1)) xcd_barrier(bar); } while (0)

    if (IN(0)) { phase0(C); } SEAM(0);
    if (IN(1)) { phase0b(C); } SEAM(1);
    if (IN(2)) {
        pg8::Gemm g{(const pg8::bf16_t*)(ARG_WS + WS_H), (const pg8::bf16_t*)(ARG_WS + WS_WIN), M, NPROJ, D}; pg8::StaticOrder S; S.init(M, NPROJ, C.G, C.wg);
        pg8::EpiBf16<0> E{(pg8::bf16_t*)(ARG_WS + WS_PROJ), NPROJ, nullptr, 0, 0, 1.f};
        pg8::gemm_phase<pg8::EpiBf16<0>, pg8::StaticOrder, true, true>(C.lds, g, S, E);
        glr_simple(C);
    } SEAM(2);
    if (IN(3)) { conv_phase(C); if (C.wg < BATCH * NH) gla_recurrent(C, C.wg); } SEAM(3);
    if (IN(4)) {
        pg8::Gemm g{(const pg8::bf16_t*)(ARG_WS + WS_H), (const pg8::bf16_t*)(ARG_WS + WS_WOUT), M, D, D}; pg8::StaticOrder S; S.init(M, D, C.G, C.wg);
        EpiF32 E{ARG_OUT, D};
        pg8::gemm_phase<EpiF32, pg8::StaticOrder, true, true>(C.lds, g, S, E);
    } SEAM(4);
    if (IN(5)) { ln1_phase(C); } SEAM(5);
    if (IN(6)) {
        pg8::Gemm g{(const pg8::bf16_t*)(ARG_WS + WS_H2), (const pg8::bf16_t*)(ARG_WS + WS_WQ), M, NQ, D}; pg8::StaticOrder S; S.init(M, NQ, C.G, C.wg);
        pg8::EpiBf16<0> E{(pg8::bf16_t*)ARG_OUT, NQ, nullptr, 0, 0, 1.f};
        pg8::gemm_phase<pg8::EpiBf16<0>, pg8::StaticOrder, true, true>(C.lds, g, S, E);
    } SEAM(6);
    if (IN(7)) { route_phase(C); } SEAM(7);
    if (IN(8)) { peer_phase(C); }
#undef IN
#undef SEAM
}

extern "C" void kernel_launch(void* const* d_in, const int* in_sizes, int n_in, void* d_out, int out_size, void* d_ws, size_t ws_size, hipStream_t stream) {
    static int grid = 0;
    if (grid == 0) {
        int dev = 0, cus = 0;
        if (n_in != 18 || out_size != M * D || ws_size < 256 * MiB) { fprintf(stderr, "kernel_launch: unexpected problem (n_in %d out %d ws %zu)\n", n_in, out_size, ws_size); grid = -1; return; }
        if (hipGetDevice(&dev) != hipSuccess || hipDeviceGetAttribute(&cus, hipDeviceAttributeMultiprocessorCount, dev) != hipSuccess) { grid = -1; return; }
        if (hipFuncSetAttribute((const void*)mk_fwd, hipFuncAttributeMaxDynamicSharedMemorySize, LDS_BYTES) != hipSuccess) { fprintf(stderr, "kernel_launch: hipFuncSetAttribute failed\n"); grid = -1; return; }
        int per_cu = 0;
        (void)hipOccupancyMaxActiveBlocksPerMultiprocessor(&per_cu, (const void*)mk_fwd, NTHR, LDS_BYTES);
        (void)hipGetLastError();
        if (per_cu < 1) fprintf(stderr, "kernel_launch: occupancy query reports %d blocks per CU\n", per_cu);
        grid = cus;
    }
    if (grid < 0) return;
    (void)hipMemsetAsync((char*)d_ws + WS_CTL, 0, CTL_ZERO_BYTES, stream);
    Args a{};
    for (int i = 0; i < 18; ++i) a.in[i] = (const float*)d_in[i];
    a.out = (float*)d_out; a.ws = (unsigned char*)d_ws;
    for (int li = 0; li < N_LAUNCHES; ++li) {
        a.ph_lo = (N_LAUNCHES == 1) ? 0 : li; a.ph_hi = (N_LAUNCHES == 1) ? NPH : li + 1;
        hipLaunchKernelGGL(mk_fwd, dim3(grid), dim3(NTHR), LDS_BYTES, stream, a);
    }
}
```

```cpp
#include <hip/hip_runtime.h>
#include <cstdio>
#include <cstdint>
#include <cmath>
namespace pg8 {
#define PG8_LAS __attribute__((address_space(3)))
typedef unsigned short bf16_t;
typedef short bf16x8 __attribute__((ext_vector_type(8)));
typedef float f32x4 __attribute__((ext_vector_type(4)));
typedef unsigned u32x4 __attribute__((ext_vector_type(4)));
constexpr int BM = 256, BK = 64, HALF = 128, HTB = HALF * BK * 2  , STAGE_BYTES = 8 * HTB, NXCD = 8, WGM = 8;

__host__ __device__ __forceinline__ int lds_byte(int r, int c) { const int st = (r >> 4) * 2 + (c >> 5), rr = r & 15, cc = c & 31, ob = rr * 64 + cc * 2; return st * 1024 + (ob ^ (((ob >> 9) & 1) << 5)); }
__host__ __device__ __forceinline__ void stage_rc(int b, int& R, int& C) { const int st = b / 1024, sb = b % 1024, swz = sb ^ (((sb >> 9) & 1) << 5); R = (st >> 1) * 16 + swz / 64; C = (st & 1) * 32 + (swz % 64) / 2; }
__host__ __device__ __forceinline__ int perm32(int rho) { const int n = rho >> 4, i = rho & 15; return 8 * (i >> 2) + 4 * n + (i & 3); }

struct Unit { int pm, pn; };
struct Gemm { const bf16_t* A; const bf16_t* Bt; int M, N, K; };

struct StaticOrder {
    int nM, nN, nwg, G, c;
    __host__ __device__ void init(int M, int N, int G_, int c_) { nM = M / BM; nN = N / BM; nwg = nM * nN; G = G_; c = c_; }
    __host__ __device__ bool next(int i, Unit& u) const {
        const long L = (long)i * G + c; if (L >= nwg) return false;
        int wgid = (int)L; { const int q = nwg / NXCD, r = nwg % NXCD, xcd = wgid % NXCD, off = wgid / NXCD; wgid = (xcd < r ? xcd * (q + 1) : r * (q + 1) + (xcd - r) * q) + off; }
        const int nig = WGM * nN, gid = wgid / nig, fm = gid * WGM, gsz = (nM - fm) < WGM ? (nM - fm) : WGM;
        u.pm = fm + ((wgid % nig) % gsz); u.pn = (wgid % nig) / gsz; return true;
    }
    __device__ __forceinline__ void a_ready(const Unit&) const {}
    __device__ __forceinline__ void done(const Unit&) const {}
};

__device__ __forceinline__ unsigned cvt_pk_bf16(float lo, float hi) { unsigned r; asm volatile("v_cvt_pk_bf16_f32 %0, %1, %2" : "=v"(r) : "v"(lo), "v"(hi)); return r; }
typedef float f32x2 __attribute__((ext_vector_type(2)));
__device__ __forceinline__ f32x2 gelu_pk(f32x2 v) {
    const f32x2 av = __builtin_elementwise_abs(v), d = av * 0.2316418882f + 1.0f;
    f32x2 t; t.x = __builtin_amdgcn_rcpf(d.x); t.y = __builtin_amdgcn_rcpf(d.y);
    f32x2 q = t * 0.5307027145f + (-0.7265760135f); q = q * t + 0.7107068705f; q = q * t + (-0.142248368f); q = q * t + 0.127414796f; q = q * t;
    const f32x2 s = (v * v) * (-0.72134752044f);
    f32x2 e; e.x = __builtin_amdgcn_exp2f(s.x); e.y = __builtin_amdgcn_exp2f(s.y);
    const f32x2 m = v * (q * e), r = v - m;
    f32x2 o; o.x = v.x < 0.f ? m.x : r.x; o.y = v.y < 0.f ? m.y : r.y; return o;
}

template <int ACT  > struct EpiBf16 {
    static constexpr bool PERM = true, AFTER_DRAIN = false; static_assert(ACT == 0 || ACT == 1, "EpiBf16: ACT is 0 (none) or 1 (gelu_pk)");
    bf16_t* O; int ldc; const float* bias; int split_cols; size_t split_stride; float scale0;
    __device__ __forceinline__ void operator()(const f32x4 (&acc)[2][2][4][2], const Unit& u, int wr, int wc, int fr, int fq) const {
        const int row0 = u.pm * BM + wr * 64 + fr; int colt = u.pn * BM; bf16_t* base = O;
        float sc = 1.f; if (split_cols) { const int t = colt / split_cols; base += (size_t)t * split_stride; colt -= t * split_cols; if (t == 0) sc = scale0; }
        const int col0 = colt + wc * 32 + 8 * fq, bcol0 = u.pn * BM + wc * 32 + 8 * fq;
        f32x4 bv[2][2];
#pragma unroll
        for (int bj = 0; bj < 2; ++bj)
#pragma unroll
            for (int n = 0; n < 2; ++n) bv[bj][n] = bias ? *(const f32x4*)(bias + bcol0 + bj * HALF + 4 * n) : (f32x4){0.f, 0.f, 0.f, 0.f};
#pragma unroll
        for (int ai = 0; ai < 2; ++ai)
#pragma unroll
            for (int m = 0; m < 4; ++m) { bf16_t* rowp = base + (size_t)(row0 + ai * HALF + m * 16) * ldc + col0;
#pragma unroll
                for (int bj = 0; bj < 2; ++bj) { f32x4 v0 = acc[ai][bj][m][0] + bv[bj][0], v1 = acc[ai][bj][m][1] + bv[bj][1];
                    if (ACT == 1) { f32x2 a = gelu_pk((f32x2){v0[0], v0[1]}), b = gelu_pk((f32x2){v0[2], v0[3]}), c = gelu_pk((f32x2){v1[0], v1[1]}), d = gelu_pk((f32x2){v1[2], v1[3]});
                        v0 = (f32x4){a.x, a.y, b.x, b.y}; v1 = (f32x4){c.x, c.y, d.x, d.y}; }
                    v0 = v0 * sc; v1 = v1 * sc; u32x4 w; w.x = cvt_pk_bf16(v0[0], v0[1]); w.y = cvt_pk_bf16(v0[2], v0[3]); w.z = cvt_pk_bf16(v1[0], v1[1]); w.w = cvt_pk_bf16(v1[2], v1[3]);
                    *(u32x4*)(rowp + bj * HALF) = w; } }
    }
};

struct PanelStats {
    unsigned* xbuf;
    unsigned* cnt;
    unsigned* tmo;
    int ntn; float eps;
    unsigned code;
    __device__ __forceinline__ bool run(const f32x4 (&v)[2][2][4][2], const Unit& u, int wr, int wc, int fr, int fq, PG8_LAS unsigned char* lds, int wid, int lane) const {
        typedef float f32x2v __attribute__((ext_vector_type(2)));
        PG8_LAS f32x2v* P = (PG8_LAS f32x2v*)lds;
        PG8_LAS f32x2v* S = (PG8_LAS f32x2v*)(lds + 8192);
        PG8_LAS unsigned* flag = (PG8_LAS unsigned*)(lds + 8192 + 2048);
#pragma unroll
        for (int ai = 0; ai < 2; ++ai)
#pragma unroll
            for (int m = 0; m < 4; ++m) {
                float s = 0.f;
#pragma unroll
                for (int bj = 0; bj < 2; ++bj)
#pragma unroll
                    for (int n = 0; n < 2; ++n) { const f32x4 x = v[ai][bj][m][n]; s += (x[0] + x[1]) + (x[2] + x[3]); }
                s += __shfl_xor(s, 16); s += __shfl_xor(s, 32);
                const float mw = s * (1.0f / 64.0f); float q = 0.f;
#pragma unroll
                for (int bj = 0; bj < 2; ++bj)
#pragma unroll
                    for (int n = 0; n < 2; ++n) { const f32x4 d = v[ai][bj][m][n] - mw; q += (d[0] * d[0] + d[1] * d[1]) + (d[2] * d[2] + d[3] * d[3]); }
                q += __shfl_xor(q, 16); q += __shfl_xor(q, 32);
                if (fq == 0) P[(ai * HALF + wr * 64 + m * 16 + fr) * 4 + wc] = (f32x2v){mw, q};
            }
        asm volatile("s_waitcnt lgkmcnt(0)" ::: "memory"); __builtin_amdgcn_s_barrier(); asm volatile("" ::: "memory");
#if defined(BROKEN_EXCHANGE_NO_WAIT)
#warning BROKEN CONTROL BUILD: the row-statistics exchange does not wait; results are wrong by design
        if (blockIdx.x >= 64) { const long long t0_ = clock64(); while (clock64() - t0_ < 60000) __builtin_amdgcn_s_sleep(8); }
#endif
        const int row = wid * 32 + (lane & 31);
        if (lane < 32) {
            const f32x2v a = P[row * 4 + 0], b = P[row * 4 + 1], c = P[row * 4 + 2], d = P[row * 4 + 3];
            const float mt = (a.x + b.x + c.x + d.x) * 0.25f;
            const float da = a.x - mt, db = b.x - mt, dc = c.x - mt, dd = d.x - mt;
            const float m2 = (a.y + b.y) + (c.y + d.y) + 64.0f * ((da * da + db * db) + (dc * dc + dd * dd));
            unsigned long long* slot = (unsigned long long*)xbuf + ((size_t)(u.pm * BM + row) * 4 + u.pn);
            __hip_atomic_store(slot, ((unsigned long long)__float_as_uint(m2) << 32) | __float_as_uint(mt), __ATOMIC_RELAXED, __HIP_MEMORY_SCOPE_AGENT);
        }
        asm volatile("s_waitcnt vmcnt(0)" ::: "memory");
        if (lane == 0) __hip_atomic_fetch_add(cnt + 64 * u.pm, 1u, __ATOMIC_RELAXED, __HIP_MEMORY_SCOPE_AGENT);
        if (wid == 0) {
            bool dead = false; const unsigned long long t0 = __builtin_amdgcn_s_memrealtime(); const unsigned want = 8u * (unsigned)ntn;
            for (;;) {
#if defined(BROKEN_EXCHANGE_NO_WAIT)
                break;
#endif
                if ((unsigned)__builtin_amdgcn_readfirstlane(__hip_atomic_load(cnt + 64 * u.pm, __ATOMIC_RELAXED, __HIP_MEMORY_SCOPE_AGENT)) >= want) break;
                if (__builtin_amdgcn_s_memrealtime() - t0 > 2000000ull) {
                    if (lane == 0) { unsigned expect = 0u; __hip_atomic_compare_exchange_strong(tmo + 1, &expect, code | (unsigned)(u.pm & 0xff), __ATOMIC_RELAXED, __ATOMIC_RELAXED, __HIP_MEMORY_SCOPE_AGENT);
                                     __hip_atomic_store(tmo, 1u, __ATOMIC_RELAXED, __HIP_MEMORY_SCOPE_AGENT); }
                    dead = true; break; }
                __builtin_amdgcn_s_sleep(2);
            }
            __builtin_amdgcn_fence(__ATOMIC_ACQUIRE, "agent");
            if (lane == 0) flag[0] = dead ? 1u : 0u;
        }
        asm volatile("s_waitcnt vmcnt(0) lgkmcnt(0)" ::: "memory"); __builtin_amdgcn_s_barrier(); asm volatile("" ::: "memory");
        const bool bad = flag[0] != 0u;
        if (lane < 32) {
            const unsigned long long* slot = (const unsigned long long*)xbuf + (size_t)(u.pm * BM + row) * 4; float mt[4], m2[4]; float ms = 0.f;
#pragma unroll
            for (int t = 0; t < 4; ++t) { if (t < ntn) { const unsigned long long w = __hip_atomic_load(slot + t, __ATOMIC_RELAXED, __HIP_MEMORY_SCOPE_AGENT); mt[t] = __uint_as_float((unsigned)w); m2[t] = __uint_as_float((unsigned)(w >> 32)); } else { mt[t] = 0.f; m2[t] = 0.f; } ms += mt[t]; }
            const float mean = ms / (float)ntn; float q = 0.f;
#pragma unroll
            for (int t = 0; t < 4; ++t) if (t < ntn) { const float dm = mt[t] - mean; q += m2[t] + 256.0f * dm * dm; }
            S[row] = (f32x2v){mean, 1.0f / sqrtf(q / (256.0f * (float)ntn) + eps)};
        }
        asm volatile("s_waitcnt lgkmcnt(0)" ::: "memory"); __builtin_amdgcn_s_barrier(); asm volatile("" ::: "memory");
        return bad;
    }
};
struct EpiLnRes {
    static constexpr bool PERM = false, AFTER_DRAIN = true;
    const float* base; float* out; int ldc; const float* bias; PanelStats st; unsigned poison;
    __device__ __forceinline__ void fused(f32x4 (&acc)[2][2][4][2], const Unit& u, int wr, int wc, int fr, int fq, PG8_LAS unsigned char* lds, int wid, int lane) const {
        typedef float f32x2v __attribute__((ext_vector_type(2)));
        const PG8_LAS f32x2v* S = (const PG8_LAS f32x2v*)(lds + 8192);
        const int col0 = u.pn * BM + wc * 32 + 4 * fq;
#pragma unroll
        for (int bj = 0; bj < 2; ++bj)
#pragma unroll
            for (int n = 0; n < 2; ++n) { const f32x4 bv = bias ? *(const f32x4*)(bias + col0 + bj * HALF + n * 16) : (f32x4){0.f, 0.f, 0.f, 0.f};
#pragma unroll
                for (int ai = 0; ai < 2; ++ai)
#pragma unroll
                    for (int m = 0; m < 4; ++m) acc[ai][bj][m][n] += bv; }
        f32x4 pre[4][2][2];
#pragma unroll
        for (int m = 0; m < 4; ++m) { const size_t off = (size_t)(u.pm * BM + wr * 64 + m * 16 + fr) * ldc + col0;
#pragma unroll
            for (int bj = 0; bj < 2; ++bj)
#pragma unroll
                for (int n = 0; n < 2; ++n) pre[m][bj][n] = *(const f32x4*)(base + off + bj * HALF + n * 16); }
        const bool bad = st.run(acc, u, wr, wc, fr, fq, lds, wid, lane) || poison != 0u;
        const float qnan = __builtin_nanf("");
#pragma unroll
        for (int ai = 0; ai < 2; ++ai)
#pragma unroll
            for (int m = 0; m < 4; ++m) { const int r = ai * HALF + wr * 64 + m * 16 + fr; const f32x2v sr = S[r]; const size_t off = (size_t)(u.pm * BM + r) * ldc + col0;
#pragma unroll
                for (int bj = 0; bj < 2; ++bj)
#pragma unroll
                    for (int n = 0; n < 2; ++n) { const f32x4 bs = ai == 0 ? pre[m][bj][n] : *(const f32x4*)(base + off + bj * HALF + n * 16); f32x4 o = bs + (acc[ai][bj][m][n] - sr.x) * sr.y;
                        if (bad) o = (f32x4){qnan, qnan, qnan, qnan}; *(f32x4*)(out + off + bj * HALF + n * 16) = o; }
                if (m & 1) asm volatile("" ::: "memory"); }
    }
};
struct EpiLnResLn {
    static constexpr bool PERM = false, AFTER_DRAIN = true;
    const float* base; float* out; bf16_t* xn; int ldc; const float* bias; PanelStats st1, st2; unsigned poison;
    __device__ __forceinline__ void fused(f32x4 (&acc)[2][2][4][2], const Unit& u, int wr, int wc, int fr, int fq, PG8_LAS unsigned char* lds, int wid, int lane) const {
        typedef float f32x2v __attribute__((ext_vector_type(2))); typedef unsigned u32x2v __attribute__((ext_vector_type(2)));
        const PG8_LAS f32x2v* S = (const PG8_LAS f32x2v*)(lds + 8192);
        const int col0 = u.pn * BM + wc * 32 + 4 * fq;
#pragma unroll
        for (int bj = 0; bj < 2; ++bj)
#pragma unroll
            for (int n = 0; n < 2; ++n) { const f32x4 bv = bias ? *(const f32x4*)(bias + col0 + bj * HALF + n * 16) : (f32x4){0.f, 0.f, 0.f, 0.f};
#pragma unroll
                for (int ai = 0; ai < 2; ++ai)
#pragma unroll
                    for (int m = 0; m < 4; ++m) acc[ai][bj][m][n] += bv; }
        bool bad = st1.run(acc, u, wr, wc, fr, fq, lds, wid, lane) || poison != 0u;
        const float qnan = __builtin_nanf("");
#pragma unroll
        for (int ai = 0; ai < 2; ++ai)
#pragma unroll
            for (int m = 0; m < 4; ++m) { const int r = ai * HALF + wr * 64 + m * 16 + fr; const f32x2v sr = S[r]; const size_t off = (size_t)(u.pm * BM + r) * ldc + col0;
#pragma unroll
                for (int bj = 0; bj < 2; ++bj)
#pragma unroll
                    for (int n = 0; n < 2; ++n) { const f32x4 bs = *(const f32x4*)(base + off + bj * HALF + n * 16); acc[ai][bj][m][n] = bs + (acc[ai][bj][m][n] - sr.x) * sr.y; }
                asm volatile("" : "+v"(acc[ai][0][m][0]), "+v"(acc[ai][0][m][1]), "+v"(acc[ai][1][m][0]), "+v"(acc[ai][1][m][1]));
                if (m & 1) asm volatile("" ::: "memory"); }
        const bool bad1 = bad;
        bad = st2.run(acc, u, wr, wc, fr, fq, lds, wid, lane) || bad;
#pragma unroll
        for (int ai = 0; ai < 2; ++ai)
#pragma unroll
            for (int m = 0; m < 4; ++m) { const int r = ai * HALF + wr * 64 + m * 16 + fr; const f32x2v sr = S[r]; const size_t off = (size_t)(u.pm * BM + r) * ldc + col0;
#pragma unroll
                for (int bj = 0; bj < 2; ++bj)
#pragma unroll
                    for (int n = 0; n < 2; ++n) { const f32x4 x1 = acc[ai][bj][m][n]; *(f32x4*)(out + off + bj * HALF + n * 16) = bad1 ? (f32x4){qnan, qnan, qnan, qnan} : x1;
                        const f32x4 o = (x1 - sr.x) * sr.y; u32x2v w; w.x = cvt_pk_bf16(o[0], o[1]); w.y = cvt_pk_bf16(o[2], o[3]);
                        if (bad) { w.x = 0x7fc07fc0u; w.y = 0x7fc07fc0u; } *(u32x2v*)(xn + off + bj * HALF + n * 16) = w; }
                asm volatile("" ::: "memory"); }
    }
};

template <class Epi, class Sched, bool ALIGN_EPI = false, bool SP2 = false>
__device__ __forceinline__ void gemm_phase(PG8_LAS unsigned char* lds, const Gemm g, const Sched& S, const Epi& E) {
    const int tid = threadIdx.x, wid = __builtin_amdgcn_readfirstlane(tid >> 6), lane = tid & 63, wr = wid >> 2, wc = wid & 3, fr = lane & 15, fq = lane >> 4;
    const int K = g.K, nt = K / BK;
    unsigned voffA[2], voffB[2];
#pragma unroll
    for (int i = 0; i < 2; ++i) { int R, C; stage_rc(tid * 16 + i * 8192, R, C); const int Rb = Epi::PERM ? ((R & ~31) + perm32(R & 31)) : R;
        voffA[i] = (unsigned)(R * K + C) * 2u; voffB[i] = (unsigned)(Rb * K + C) * 2u; }
    const size_t kstep = (size_t)(BK * 2);
    const size_t hstep = (size_t)HALF * K * 2;
    const size_t tstep = 2 * hstep;
    const unsigned ldsw = (unsigned)wid * 1024u;
    const int aoff = lds_byte(wr * 64 + fr, fq * 8), boff = lds_byte(wc * 32 + fr, fq * 8);
#define PG8_SA(b, h) (((b) * 2 + (h)) * HTB)
#define PG8_SB(b, h) ((4 + (b) * 2 + (h)) * HTB)
#define PG8_STAGE(bufoff, gbase, voff) do { _Pragma("unroll") for (int _i = 0; _i < 2; ++_i) \
        __builtin_amdgcn_global_load_lds((const unsigned*)((const char*)(gbase) + (voff)[_i]), (PG8_LAS unsigned*)(lds + (bufoff) + ldsw + _i * 8192), 16, 0, 0); } while (0)
#define PG8_LDA(dst, b, h) do { _Pragma("unroll") for (int m = 0; m < 4; ++m) _Pragma("unroll") for (int k = 0; k < 2; ++k) dst[m][k] = *(const PG8_LAS bf16x8*)(lds + PG8_SA(b, h) + aoff + m * 2048 + k * 1024); } while (0)
#define PG8_LDB(dst, b, h) do { _Pragma("unroll") for (int n = 0; n < 2; ++n) _Pragma("unroll") for (int k = 0; k < 2; ++k) dst[n][k] = *(const PG8_LAS bf16x8*)(lds + PG8_SB(b, h) + boff + n * 2048 + k * 1024); } while (0)
#define PG8_MMA(ai, bj, At, Bt) do { __builtin_amdgcn_s_setprio(1); _Pragma("unroll") for (int m = 0; m < 4; ++m) _Pragma("unroll") for (int n = 0; n < 2; ++n) _Pragma("unroll") for (int k = 0; k < 2; ++k) \
        acc[ai][bj][m][n] = __builtin_amdgcn_mfma_f32_16x16x32_bf16(Bt[n][k], At[m][k], acc[ai][bj][m][n], 0, 0, 0); __builtin_amdgcn_s_setprio(0); } while (0)
#define PG8_WAIT_V(n) asm volatile("s_waitcnt vmcnt(" #n ")" ::: "memory")
#define PG8_WAIT_L(n) asm volatile("s_waitcnt lgkmcnt(" #n ")" ::: "memory")
#define PG8_BAR __builtin_amdgcn_s_barrier()
#define PG8_SCHED __builtin_amdgcn_sched_barrier(0)
    Unit cur, nxt; int ui = 0;
    if (!S.next(0, cur)) return;
    f32x4 acc[2][2][4][2];
#pragma unroll
    for (int a = 0; a < 2; ++a)
#pragma unroll
        for (int b = 0; b < 2; ++b)
#pragma unroll
            for (int m = 0; m < 4; ++m)
#pragma unroll
                for (int n = 0; n < 2; ++n) acc[a][b][m][n] = (f32x4){0.f, 0.f, 0.f, 0.f};
    bf16x8 At[4][2], B0[2][2], B1[2][2];
    const char* cA = (const char*)g.A + (size_t)cur.pm * tstep; const char* cB = (const char*)g.Bt + (size_t)cur.pn * tstep;
    S.a_ready(cur);
    if constexpr (SP2) {
        PG8_STAGE(PG8_SB(0, 0), cB, voffB); PG8_STAGE(PG8_SB(0, 1), cB + hstep, voffB); PG8_STAGE(PG8_SA(0, 0), cA, voffA); PG8_STAGE(PG8_SA(0, 1), cA + hstep, voffA);
        if (wr == 1) PG8_BAR;
        PG8_WAIT_V(2); PG8_BAR;
        PG8_STAGE(PG8_SB(1, 0), cB + kstep, voffB); PG8_STAGE(PG8_SA(1, 0), cA + kstep, voffA); PG8_STAGE(PG8_SB(1, 1), cB + hstep + kstep, voffB);
        PG8_WAIT_V(6); PG8_BAR;
    } else {
        PG8_STAGE(PG8_SB(0, 0), cB, voffB); PG8_STAGE(PG8_SA(0, 0), cA, voffA); PG8_STAGE(PG8_SB(0, 1), cB + hstep, voffB); PG8_STAGE(PG8_SA(0, 1), cA + hstep, voffA);
        if (wr == 1) PG8_BAR;
        PG8_WAIT_V(4); PG8_BAR;
        PG8_STAGE(PG8_SB(1, 0), cB + kstep, voffB); PG8_STAGE(PG8_SA(1, 0), cA + kstep, voffA); PG8_STAGE(PG8_SB(1, 1), cB + hstep + kstep, voffB);
        PG8_WAIT_V(6); PG8_BAR;
    }
    for (;;) {
        const bool has_next = S.next(ui + 1, nxt);
        const char* nA = has_next ? (const char*)g.A + (size_t)nxt.pm * tstep : cA; const char* nB = has_next ? (const char*)g.Bt + (size_t)nxt.pn * tstep : cB;
        for (int t = 0; t < nt; t += 2) {
            const bool last = (t == nt - 2);
            const char* a1 = cA + (size_t)(t + 1) * kstep;
            const char* a2 = last ? nA : cA + (size_t)(t + 2) * kstep; const char* b2 = last ? nB : cB + (size_t)(t + 2) * kstep;
            const char* a3 = a2 + kstep; const char* b3 = b2 + kstep;
            if (last && has_next) S.a_ready(nxt);
            if constexpr (SP2) {
            PG8_LDB(B0, 0, 0); PG8_LDB(B1, 0, 1); PG8_SCHED; PG8_LDA(At, 0, 0); PG8_STAGE(PG8_SA(1, 1), a1 + hstep, voffA);
            PG8_WAIT_V(8); PG8_WAIT_L(0); PG8_BAR; PG8_MMA(0, 0, At, B0); PG8_MMA(0, 1, At, B1); PG8_BAR; PG8_SCHED;
            PG8_LDA(At, 0, 1); PG8_STAGE(PG8_SB(0, 0), b2, voffB); PG8_STAGE(PG8_SB(0, 1), b2 + hstep, voffB); PG8_STAGE(PG8_SA(0, 0), a2, voffA);
            PG8_WAIT_V(8); PG8_WAIT_L(0); PG8_BAR; PG8_MMA(1, 0, At, B0); PG8_MMA(1, 1, At, B1); PG8_BAR; PG8_SCHED;
            PG8_LDB(B0, 1, 0); PG8_LDB(B1, 1, 1); PG8_SCHED; PG8_LDA(At, 1, 0); PG8_STAGE(PG8_SA(0, 1), a2 + hstep, voffA);
            PG8_WAIT_V(8); PG8_WAIT_L(0); PG8_BAR; PG8_MMA(0, 0, At, B0); PG8_MMA(0, 1, At, B1); PG8_BAR; PG8_SCHED;
            PG8_LDA(At, 1, 1); PG8_STAGE(PG8_SB(1, 0), b3, voffB); PG8_STAGE(PG8_SB(1, 1), b3 + hstep, voffB); PG8_STAGE(PG8_SA(1, 0), a3, voffA);
            PG8_WAIT_V(8); PG8_WAIT_L(0); PG8_BAR; PG8_MMA(1, 0, At, B0); PG8_MMA(1, 1, At, B1); PG8_BAR; PG8_SCHED;
            } else {
            PG8_LDB(B0, 0, 0); PG8_SCHED; PG8_LDA(At, 0, 0); PG8_STAGE(PG8_SA(1, 1), a1 + hstep, voffA);
            PG8_WAIT_L(8); PG8_BAR; PG8_WAIT_L(0); PG8_MMA(0, 0, At, B0); PG8_BAR; PG8_SCHED;
            PG8_LDB(B1, 0, 1); PG8_STAGE(PG8_SB(0, 0), b2, voffB);
            PG8_BAR; PG8_WAIT_L(0); PG8_MMA(0, 1, At, B1); PG8_BAR;
            PG8_LDA(At, 0, 1); PG8_STAGE(PG8_SA(0, 0), a2, voffA);
            PG8_BAR; PG8_WAIT_L(0); PG8_MMA(1, 0, At, B0); PG8_BAR; PG8_SCHED;
            PG8_STAGE(PG8_SB(0, 1), b2 + hstep, voffB);
            PG8_WAIT_V(6); PG8_BAR; PG8_MMA(1, 1, At, B1); PG8_BAR;
            PG8_LDB(B0, 1, 0); PG8_SCHED; PG8_LDA(At, 1, 0); PG8_STAGE(PG8_SA(0, 1), a2 + hstep, voffA);
            PG8_WAIT_L(8); PG8_BAR; PG8_WAIT_L(0); PG8_MMA(0, 0, At, B0); PG8_BAR; PG8_SCHED;
            PG8_LDB(B1, 1, 1); PG8_STAGE(PG8_SB(1, 0), b3, voffB);
            PG8_BAR; PG8_WAIT_L(0); PG8_MMA(0, 1, At, B1); PG8_BAR;
            PG8_LDA(At, 1, 1); PG8_STAGE(PG8_SA(1, 0), a3, voffA);
            PG8_BAR; PG8_WAIT_L(0); PG8_MMA(1, 0, At, B0); PG8_BAR; PG8_SCHED;
            PG8_STAGE(PG8_SB(1, 1), b3 + hstep, voffB);
            PG8_WAIT_V(6); PG8_BAR; PG8_MMA(1, 1, At, B1); PG8_BAR;
            }
        }
        if constexpr (ALIGN_EPI) { if (wr == 0) PG8_BAR; }
        if constexpr (!Epi::AFTER_DRAIN) { E(acc, cur, wr, wc, fr, fq); S.done(cur); }
        if (!has_next) break;
#pragma unroll
        for (int a = 0; a < 2; ++a)
#pragma unroll
            for (int b = 0; b < 2; ++b)
#pragma unroll
                for (int m = 0; m < 4; ++m)
#pragma unroll
                    for (int n = 0; n < 2; ++n) acc[a][b][m][n] = (f32x4){0.f, 0.f, 0.f, 0.f};
        cur = nxt; cA = nA; cB = nB; ++ui;
        if constexpr (ALIGN_EPI) { if (wr == 1) PG8_BAR; }
    }
    PG8_WAIT_V(0);
    if constexpr (!ALIGN_EPI) { if (wr == 0) PG8_BAR; }
    PG8_BAR;
    if constexpr (Epi::AFTER_DRAIN) { E.fused(acc, cur, wr, wc, fr, fq, lds, wid, lane); S.done(cur); }
#undef PG8_SA
#undef PG8_SB
#undef PG8_STAGE
#undef PG8_LDA
#undef PG8_LDB
#undef PG8_MMA
#undef PG8_WAIT_V
#undef PG8_WAIT_L
#undef PG8_BAR
#undef PG8_SCHED
}
}
#define LAS __attribute__((address_space(3)))
#define GAS __attribute__((address_space(1)))
#define XB_TMO      128
#define XB_XCNT(j)  (256  + 64 * (j))
#define XB_XSUB(j)  (1280 + 64 * (j))
#define XB_XGEN(j)  (2304 + 64 * (j))
#define XB_TOP      3328
#define XB_TOPGEN   3392
#define XCD_BAR_WORDS 3456
#define XB_SPIN_CAP (1u << 18)
typedef unsigned short bf16;
typedef unsigned v4u __attribute__((ext_vector_type(4)));
typedef unsigned v2u __attribute__((ext_vector_type(2)));
typedef float f32x4 __attribute__((ext_vector_type(4)));
typedef float f32x16 __attribute__((ext_vector_type(16)));
typedef short bf16x8 __attribute__((ext_vector_type(8)));

constexpr int NWAVES = 8, NTHR = 512;
constexpr int D = 1024, BATCH = 8, SEQ = 2048, M = BATCH * SEQ;
constexpr int CONVW = 512, GK = 256, NH = 4, DK = 64, DV = 128, RANK = 16;
constexpr int INC = 3088, NPROJ = 3072;
constexpr int PH = 8, NKEYS = 128, TOPK = 16, NQ = 2048;
constexpr float LN_EPS = 1e-5f, RMS_EPS = 1e-6f;
constexpr float ALPHA = 1.189207115002721f;
constexpr size_t MiB = 1u << 20;
constexpr size_t WS_CTL = 0, CTL_ZERO_BYTES = 1 * MiB;
constexpr size_t WS_MOD = 1 * MiB;
constexpr size_t WS_WIN = 2 * MiB;
constexpr size_t WS_WGLR = 8 * MiB;
constexpr size_t WS_WOUT = 9 * MiB;
constexpr size_t WS_WQ = 11 * MiB;
constexpr size_t WS_SUBK = 15 * MiB;
constexpr size_t WS_PU = 16 * MiB, WS_PV = 48 * MiB;
constexpr size_t WS_H = 80 * MiB;
constexpr size_t WS_PROJ = 112 * MiB;
constexpr size_t WS_X1 = 112 * MiB;
constexpr size_t WS_H2 = 176 * MiB;
constexpr size_t WS_GLR = 208 * MiB;
constexpr size_t WS_IDX = 209 * MiB, WS_GATE = 217 * MiB;
constexpr int CW_BAR = 4096;

constexpr int RING_BYTES = 131072, LDSCTL_OFF = RING_BYTES, MISC_OFF = LDSCTL_OFF + 320, LDS_BYTES = 147456;

__device__ __forceinline__ unsigned f2bf(float f) { unsigned u = __builtin_bit_cast(unsigned, f); return (u + 0x7fffu + ((u >> 16) & 1u)) >> 16; }
__device__ __forceinline__ unsigned pk2(float lo, float hi) { return f2bf(lo) | (f2bf(hi) << 16); }
__device__ __forceinline__ float bflo(unsigned w) { return __builtin_bit_cast(float, w << 16); }
__device__ __forceinline__ float bfhi(unsigned w) { return __builtin_bit_cast(float, w & 0xffff0000u); }
__device__ __forceinline__ float bf2f(bf16 v) { return __builtin_bit_cast(float, (unsigned)v << 16); }
__device__ __forceinline__ float silu_f(float v) { return v / (1.f + __expf(-v)); }
__device__ __forceinline__ float gelu_f(float v) { return 0.5f * v * (1.f + erff(v * 0.70710678118654752f)); }
__device__ __forceinline__ float logsig_f(float z) { return fminf(z, 0.f) - log1pf(__expf(-fabsf(z))); }
__device__ __forceinline__ float wave_sum(float v) {
#pragma unroll
    for (int o = 1; o < 64; o <<= 1) v += __shfl_xor(v, o);
    return v;
}
#define LDS_WAIT() asm volatile("s_waitcnt lgkmcnt(0)" ::: "memory")


__device__ __forceinline__ unsigned xb_ld(unsigned* p)              { return __hip_atomic_load(p, __ATOMIC_RELAXED, __HIP_MEMORY_SCOPE_AGENT); }
__device__ __forceinline__ unsigned xb_add(unsigned* p, unsigned v) { return __hip_atomic_fetch_add(p, v, __ATOMIC_RELAXED, __HIP_MEMORY_SCOPE_AGENT); }
__device__ __forceinline__ unsigned xb_xcc_id() { return (unsigned)__builtin_amdgcn_s_getreg((3 << 11) | 20) & 0xFu; }
#define XB_SPIN(cond, bar) do { unsigned _sp = 0; while (cond) { __builtin_amdgcn_s_sleep(1); \
    if ((++_sp & 255u) == 0u) { if (xb_ld(&(bar)[XB_TMO])) break; if (_sp > XB_SPIN_CAP) { atomicAdd(&(bar)[XB_TMO], 1u); break; } } } } while (0)

struct XcdBarrier {
    unsigned* bar; unsigned x;
    volatile LAS unsigned* st;
};

__device__ __forceinline__ XcdBarrier xcd_barrier_post(unsigned* bar, volatile LAS unsigned* st) {
    XcdBarrier b; b.bar = bar; b.x = xb_xcc_id(); b.st = st;
    if (threadIdx.x == 0) (void)xb_add(&bar[XB_XCNT(b.x)], 1u);
    return b;
}
__device__ __forceinline__ void xcd_barrier_complete(unsigned* bar, unsigned x, unsigned& nloc, unsigned& nx) {
    const unsigned G = gridDim.x * gridDim.y * gridDim.z;
    unsigned sum, cnt, mine, sp = 0u;
    for (;;) {
        sum = 0u; cnt = 0u; mine = 0u;
#pragma unroll
        for (unsigned j = 0; j < 16; ++j) { const unsigned c = xb_ld(&bar[XB_XCNT(j)]); sum += c; cnt += (c > 0u) ? 1u : 0u; mine = (j == x) ? c : mine; }
        if (sum == G) break;
        __builtin_amdgcn_s_sleep(1);
        if ((++sp & 255u) == 0u) { if (xb_ld(&bar[XB_TMO])) break; if (sp > XB_SPIN_CAP) { atomicAdd(&bar[XB_TMO], 1u); break; } }
    }
    nloc = mine > 0u ? mine : 1u; nx = cnt > 0u ? cnt : 1u;
}

__device__ __forceinline__ void xcd_barrier(const XcdBarrier& b) {
    asm volatile("s_waitcnt vmcnt(0)" ::: "memory");
    __syncthreads();
    if (threadIdx.x == 0) {
        unsigned* bar = b.bar;
        __builtin_amdgcn_s_waitcnt(0);
        unsigned nloc = b.st[0], nx = b.st[1];
        if (nloc == 0u) { xcd_barrier_complete(bar, b.x, nloc, nx); b.st[0] = nloc; b.st[1] = nx; }
        const unsigned old = xb_add(&bar[XB_XSUB(b.x)], 1u);
        const unsigned gen = old / nloc;
        if (old + 1u == (gen + 1u) * nloc) {
            __builtin_amdgcn_fence(__ATOMIC_RELEASE, "agent");
            asm volatile("s_waitcnt vmcnt(0)" ::: "memory");
            const unsigned og = xb_add(&bar[XB_TOP], 1u);
            const unsigned tg = og / nx;
            if (og + 1u == (tg + 1u) * nx) xb_add(&bar[XB_TOPGEN], 1u);
            else XB_SPIN(xb_ld(&bar[XB_TOPGEN]) == tg, bar);
            __builtin_amdgcn_fence(__ATOMIC_ACQUIRE, "agent");
            xb_add(&bar[XB_XGEN(b.x)], 1u);
            asm volatile("s_waitcnt vmcnt(0)" ::: "memory");
        } else {
            XB_SPIN(xb_ld(&bar[XB_XGEN(b.x)]) == gen, bar);
            __builtin_amdgcn_fence(__ATOMIC_ACQUIRE, "agent");
            asm volatile("s_waitcnt vmcnt(0)" ::: "memory");
        }
    }
    __syncthreads();
}


constexpr int ARGT_OFF = LDSCTL_OFF + 1024;
enum ArgIdx { A_X = 0, A_C, A_WMOD, A_BMOD, A_WIN, A_CONVW, A_GATEUP, A_GATEBIAS, A_NORMG, A_WOUT, A_LN1G, A_LN1B, A_WQ, A_SUBK, A_PU, A_PV, A_LN2G, A_LN2B, A_OUT, A_WS, A_COUNT };
struct Ctx { LAS unsigned char* lds; int tid, lane, wave, wg, G, gw, NGW; };
__device__ __forceinline__ unsigned long long ldarg(const Ctx& C, int i) {
    volatile LAS unsigned* p = (volatile LAS unsigned*)(C.lds + ARGT_OFF) + 2 * i;
    const unsigned lo = __builtin_amdgcn_readfirstlane(p[0]), hi = __builtin_amdgcn_readfirstlane(p[1]);
    return ((unsigned long long)hi << 32) | lo;
}
#define ARGF(i) ((const float*)ldarg(C, (i)))
#define ARG_WS ((unsigned char*)ldarg(C, A_WS))
#define ARG_OUT ((float*)ldarg(C, A_OUT))

__device__ __forceinline__ void p0_mod_item(const Ctx& C, int item) {
    LAS float* sc = (LAS float*)C.lds; LAS float* red = sc + BATCH * D;
    float* mod = (float*)(ARG_WS + WS_MOD); const float* c_in = ARGF(A_C); const float* w_mod = ARGF(A_WMOD); const float* b_mod = ARGF(A_BMOD);
    for (int i = C.tid; i < BATCH * D; i += NTHR) sc[i] = silu_f(c_in[i]);
    __syncthreads();
    const int col = C.lane & 31, kp = C.lane >> 5, n0 = item * 32;
    float acc[BATCH];
#pragma unroll
    for (int b = 0; b < BATCH; ++b) acc[b] = 0.f;
    for (int i = 0; i < 64; ++i) {
        const int k = 128 * C.wave + 2 * i + kp; const float wv = w_mod[(size_t)k * (6 * D) + n0 + col];
#pragma unroll
        for (int b = 0; b < BATCH; ++b) acc[b] += sc[b * D + k] * wv;
    }
#pragma unroll
    for (int b = 0; b < BATCH; ++b) acc[b] += __shfl_xor(acc[b], 32);
    if (C.lane < 32) {
#pragma unroll
        for (int b = 0; b < BATCH; ++b) red[(C.wave * 8 + b) * 32 + col] = acc[b];
    }
    __syncthreads();
    if (C.tid < 256) { const int b = C.tid >> 5, cc = C.tid & 31; float s = b_mod[n0 + cc];
#pragma unroll
        for (int w = 0; w < 8; ++w) s += red[(w * 8 + b) * 32 + cc];
        mod[b * (6 * D) + n0 + cc] = s; }
    __syncthreads();
}
__device__ __forceinline__ void p0_transpose_item(const float* W, int ldw, int K, int k0, int n0, bf16* WT, LAS float* scr, int lane) {
#pragma unroll 8
    for (int i = 0; i < 32; ++i) { const int kk = 2 * i + (lane >> 5); scr[kk * 33 + (lane & 31)] = W[(size_t)(k0 + kk) * ldw + n0 + (lane & 31)]; }
    LDS_WAIT(); asm volatile("" ::: "memory");
    const int c = lane & 7;
#pragma unroll
    for (int j = 0; j < 4; ++j) { const int n = (lane >> 3) + 8 * j; const LAS float* s = scr + (8 * c) * 33 + n;
        v4u o; o.x = pk2(s[0 * 33], s[1 * 33]); o.y = pk2(s[2 * 33], s[3 * 33]); o.z = pk2(s[4 * 33], s[5 * 33]); o.w = pk2(s[6 * 33], s[7 * 33]);
        *(v4u*)(WT + (size_t)(n0 + n) * K + k0 + 8 * c) = o; }
    LDS_WAIT(); asm volatile("" ::: "memory");
}
__device__ __forceinline__ void p0_cvt_item(const float* src, bf16* dst, size_t item, int lane) {
#pragma unroll
    for (int r = 0; r < 4; ++r) { const size_t off = item * 2048 + r * 512 + lane * 8; const f32x4 a = *(const f32x4*)(src + off), b = *(const f32x4*)(src + off + 4);
        v4u o; o.x = pk2(a.x, a.y); o.y = pk2(a.z, a.w); o.z = pk2(b.x, b.y); o.w = pk2(b.z, b.w); *(v4u*)(dst + off) = o; }
}
__device__ __forceinline__ void phase0(const Ctx& C) {
    if (C.wg < 192) p0_mod_item(C, C.wg);
    LAS float* scr = (LAS float*)(C.lds + C.wave * 16384);
    unsigned char* ws = ARG_WS; const float* w_in = ARGF(A_WIN); const float* w_out = ARGF(A_WOUT); const float* wq = ARGF(A_WQ); const float* pu = ARGF(A_PU); const float* pv = ARGF(A_PV); const float* subkeys = ARGF(A_SUBK);
    bf16* WIN = (bf16*)(ws + WS_WIN); bf16* WOUT = (bf16*)(ws + WS_WOUT); bf16* WQ = (bf16*)(ws + WS_WQ); bf16* WGLR = (bf16*)(ws + WS_WGLR);
    bf16* PU = (bf16*)(ws + WS_PU); bf16* PV = (bf16*)(ws + WS_PV); bf16* SUBK = (bf16*)(ws + WS_SUBK);
    constexpr int I_IN = 16 * 96, I_OUT = 16 * 32, I_Q = 16 * 64, I_U = 8192, I_S = 128;
    constexpr int NITEMS = I_IN + I_OUT + I_Q + 2 * I_U + I_S;
    for (int it = C.gw; it < NITEMS; it += C.NGW) {
        int r = it;
        if (r < I_IN) { p0_transpose_item(w_in, INC, D, 64 * (r / 96), 32 * (r % 96), WIN, scr, C.lane); continue; } r -= I_IN;
        if (r < I_OUT) { p0_transpose_item(w_out, D, D, 64 * (r / 32), 32 * (r % 32), WOUT, scr, C.lane); continue; } r -= I_OUT;
        if (r < I_Q) { p0_transpose_item(wq, NQ, D, 64 * (r / 64), 32 * (r % 64), WQ, scr, C.lane); continue; } r -= I_Q;
        if (r < I_U) { p0_cvt_item(pu, PU, (size_t)r, C.lane); continue; } r -= I_U;
        if (r < I_U) { p0_cvt_item(pv, PV, (size_t)r, C.lane); continue; } r -= I_U;
        p0_cvt_item(subkeys, SUBK, (size_t)r, C.lane);
    }
    for (int i = C.gw * 64 + C.lane; i < RANK * D; i += C.NGW * 64) { const int j = i >> 10, k = i & 1023; WGLR[i] = (bf16)f2bf(w_in[(size_t)k * INC + NPROJ + j]); }
}
__device__ __forceinline__ void phase0b(const Ctx& C) {
    unsigned char* ws = ARG_WS; const float* x = ARGF(A_X);
    const float* mod = (const float*)(ws + WS_MOD); bf16* H = (bf16*)(ws + WS_H);
    for (int m = C.gw; m < M; m += C.NGW) {
        const int b = m / SEQ; const f32x4* sh = (const f32x4*)(mod + b * 6 * D) + C.lane; const f32x4* sc = (const f32x4*)(mod + b * 6 * D + D) + C.lane;
        const f32x4* xr = (const f32x4*)(x + (size_t)m * D) + C.lane;
        unsigned long long* o8 = (unsigned long long*)(H + (size_t)m * D) + C.lane;
#pragma unroll
        for (int j = 0; j < 4; ++j) { const f32x4 v = xr[64 * j] * (sc[64 * j] + 1.0f) + sh[64 * j]; o8[64 * j] = (unsigned long long)pk2(v.x, v.y) | ((unsigned long long)pk2(v.z, v.w) << 32); }
    }
}
struct EpiF32 {
    static constexpr bool PERM = false, AFTER_DRAIN = false;
    float* O; int ldc;
    __device__ __forceinline__ void operator()(const pg8::f32x4 (&acc)[2][2][4][2], const pg8::Unit& u, int wr, int wc, int fr, int fq) const {
        const int col0 = u.pn * 256 + wc * 32 + 4 * fq;
#pragma unroll
        for (int ai = 0; ai < 2; ++ai)
#pragma unroll
            for (int m = 0; m < 4; ++m) { float* rowp = O + (size_t)(u.pm * 256 + ai * 128 + wr * 64 + m * 16 + fr) * ldc + col0;
#pragma unroll
                for (int bj = 0; bj < 2; ++bj)
#pragma unroll
                    for (int n = 0; n < 2; ++n) *(pg8::f32x4*)(rowp + bj * 128 + n * 16) = acc[ai][bj][m][n]; }
    }
};
__device__ __forceinline__ void glr_simple(const Ctx& C) {
    unsigned char* ws = ARG_WS;
    const bf16* H = (const bf16*)(ws + WS_H); const bf16* WGLR = (const bf16*)(ws + WS_WGLR); float* GLR = (float*)(ws + WS_GLR);
    for (int i = C.gw * 64 + C.lane; i < M * RANK; i += C.NGW * 64) {
        const int m = i >> 4, j = i & 15; const v4u* hr = (const v4u*)(H + (size_t)m * D); const v4u* wr = (const v4u*)(WGLR + (size_t)j * D);
        float acc = 0.f;
        for (int kc = 0; kc < 128; ++kc) { const v4u a = hr[kc], w = wr[kc];
            acc += bflo(a.x) * bflo(w.x) + bfhi(a.x) * bfhi(w.x) + bflo(a.y) * bflo(w.y) + bfhi(a.y) * bfhi(w.y) + bflo(a.z) * bflo(w.z) + bfhi(a.z) * bfhi(w.z) + bflo(a.w) * bflo(w.w) + bfhi(a.w) * bfhi(w.w); }
        GLR[i] = acc;
    }
}
__device__ __forceinline__ void conv_phase(const Ctx& C) {
    unsigned char* ws = ARG_WS; const float* conv_w = ARGF(A_CONVW);
    const bf16* PROJ = (const bf16*)(ws + WS_PROJ); bf16* YMIX = (bf16*)(ws + WS_H);
    for (int i = C.gw * 64 + C.lane; i < M * 64; i += C.NGW * 64) {
        const int m = i >> 6, c = (i & 63) * 8, s = m % SEQ;
        float z[8];
#pragma unroll
        for (int k = 0; k < 8; ++k) z[k] = 0.f;
#pragma unroll
        for (int j = 0; j < 3; ++j) { const int sp = s - 2 + j;
            if (sp >= 0) { const bf16* row = PROJ + (size_t)(m - 2 + j) * NPROJ; const v4u cc = *(const v4u*)(row + CONVW + c), ch = *(const v4u*)(row + 2 * CONVW + c);
                const f32x4 w0 = *(const f32x4*)(conv_w + j * CONVW + c), w1 = *(const f32x4*)(conv_w + j * CONVW + c + 4);
                z[0] += w0.x * bflo(cc.x) * bflo(ch.x); z[1] += w0.y * bfhi(cc.x) * bfhi(ch.x); z[2] += w0.z * bflo(cc.y) * bflo(ch.y); z[3] += w0.w * bfhi(cc.y) * bfhi(ch.y);
                z[4] += w1.x * bflo(cc.z) * bflo(ch.z); z[5] += w1.y * bfhi(cc.z) * bfhi(ch.z); z[6] += w1.z * bflo(cc.w) * bflo(ch.w); z[7] += w1.w * bfhi(cc.w) * bfhi(ch.w); } }
        const v4u cb = *(const v4u*)(PROJ + (size_t)m * NPROJ + c);
        v4u o; o.x = pk2(bflo(cb.x) * z[0], bfhi(cb.x) * z[1]); o.y = pk2(bflo(cb.y) * z[2], bfhi(cb.y) * z[3]); o.z = pk2(bflo(cb.z) * z[4], bfhi(cb.z) * z[5]); o.w = pk2(bflo(cb.w) * z[6], bfhi(cb.w) * z[7]);
        *(v4u*)(YMIX + (size_t)m * D + c) = o;
    }
}
constexpr size_t GO_KV = 0, GO_SPREV = 34 * MiB, GO_DECAY = 52 * MiB;
constexpr int G_GLR = 0, G_T = 4096, G_K = 8192, G_Q = 16384, G_V = 24576, G_S = 43008, G_QE = 61440, G_KE = 70656, G_AT = 79872, G_SS = 90112;
constexpr int VS_B = 272, QS_B = 144;
typedef short v4i16_t __attribute__((ext_vector_type(4)));
__device__ __forceinline__ bf16x8 tr_frag(const LAS unsigned char* tile, int stride, int ks, int c, int lane) {
    const int g = lane >> 4, q = (lane & 15) >> 2, pp = lane & 3;
    const LAS unsigned char* a = tile + (32 * ks + 8 * g + q) * stride + (16 * c + 4 * pp) * 2;
    const v4i16_t lo = __builtin_amdgcn_ds_read_tr16_b64_v4i16((LAS v4i16_t*)a);
    const v4i16_t hi = __builtin_amdgcn_ds_read_tr16_b64_v4i16((LAS v4i16_t*)(a + 4 * stride));
    bf16x8 r; r[0] = lo[0]; r[1] = lo[1]; r[2] = lo[2]; r[3] = lo[3]; r[4] = hi[0]; r[5] = hi[1]; r[6] = hi[2]; r[7] = hi[3]; return r;
}
__device__ __forceinline__ bf16x8 row_frag(const LAS unsigned char* tile, int stride, int ks, int c, int lane) {
    return *(const LAS bf16x8*)(tile + (16 * c + (lane & 15)) * stride + (32 * ks + 8 * (lane >> 4)) * 2);
}
template <bool PASS_C>
__device__ __forceinline__ void gla_stage_prefix(const Ctx& C, const bf16* PROJ, const float* GLR, const bf16* SPREV, const float* gate_up, const float* gate_bias, int m0, int hd, int kvidx, float (&bc)[8], float& blast) {
    const int tid = C.tid;
    __syncthreads();
    if (tid < 256) *(LAS v4u*)(C.lds + G_GLR + tid * 16) = *(const v4u*)(GLR + (size_t)m0 * RANK + tid * 4);
    { const int row = tid >> 3, ch = tid & 7; const bf16* src = PROJ + (size_t)(m0 + row) * NPROJ + hd * DK + ch * 8;
      *(LAS v4u*)(C.lds + G_K + row * 128 + ch * 16) = *(const v4u*)(src + 1792);
      if (PASS_C) *(LAS v4u*)(C.lds + G_Q + row * 128 + ch * 16) = *(const v4u*)(src + 1536); }
#pragma unroll
    for (int i = 0; i < 2; ++i) { const int idx = tid + i * NTHR, row = idx >> 4, ch = idx & 15;
        *(LAS v4u*)(C.lds + G_V + row * VS_B + ch * 16) = *(const v4u*)(PROJ + (size_t)(m0 + row) * NPROJ + 2048 + hd * DV + ch * 8);
        if (PASS_C) *(LAS v4u*)(C.lds + G_S + row * VS_B + ch * 16) = *(const v4u*)(SPREV + (size_t)kvidx * (DK * DV) + row * DV + ch * 8); }
    const int d = tid & 63, rb = tid >> 6;
    float gu[RANK];
#pragma unroll
    for (int j = 0; j < RANK; ++j) gu[j] = gate_up[j * GK + hd * DK + d];
    const float bias = gate_bias[hd * DK + d];
    __syncthreads();
    float run = 0.f;
#pragma unroll
    for (int i = 0; i < 8; ++i) { const LAS float* gr = (const LAS float*)(C.lds + G_GLR) + (rb * 8 + i) * RANK; float z = bias;
#pragma unroll
        for (int j = 0; j < RANK; ++j) z += gr[j] * gu[j];
        run += logsig_f(z) * (1.f / 16.f); bc[i] = run; }
    ((LAS float*)(C.lds + G_T))[rb * 64 + d] = run;
    __syncthreads();
    float off = 0.f; blast = 0.f;
#pragma unroll
    for (int r2 = 0; r2 < 8; ++r2) { const float tv = ((const LAS float*)(C.lds + G_T))[r2 * 64 + d]; blast += tv; if (r2 < rb) off += tv; }
#pragma unroll
    for (int i = 0; i < 8; ++i) bc[i] += off;
}
__device__ __forceinline__ void gla_pass_a(const Ctx& C) {
    unsigned char* ws = ARG_WS; unsigned char* ob = (unsigned char*)ARG_OUT; const float* gate_up = ARGF(A_GATEUP); const float* gate_bias = ARGF(A_GATEBIAS);
    const bf16* PROJ = (const bf16*)(ws + WS_PROJ); const float* GLR = (const float*)(ws + WS_GLR);
    float* KV = (float*)(ob + GO_KV); float* DECAY = (float*)(ob + GO_DECAY);
    const int lane = C.lane, w = C.wave;
    for (int item = C.wg; item < BATCH * 32 * NH; item += C.G) {
        const int hd = item & 3, bn = item >> 2, b = bn >> 5, n = bn & 31, m0 = bn * 64, kvidx = (b * NH + hd) * 32 + n;
        float bc[8], blast;
        gla_stage_prefix<false>(C, PROJ, GLR, nullptr, gate_up, gate_bias, m0, hd, kvidx, bc, blast);
        const int d = C.tid & 63, rb = C.tid >> 6;
#pragma unroll
        for (int i = 0; i < 8; ++i) { const int r = rb * 8 + i; const float kk = bf2f(*(const LAS bf16*)(C.lds + G_K + r * 128 + d * 2));
            *(LAS bf16*)(C.lds + G_QE + r * QS_B + d * 2) = (bf16)f2bf(kk * __expf(blast - bc[i])); }
        if (rb == 0) DECAY[(size_t)kvidx * DK + d] = __expf(blast);
        __syncthreads();
        const int dt = w & 3, e0 = (w >> 2) * 4;
        f32x4 acc[4];
#pragma unroll
        for (int j = 0; j < 4; ++j) acc[j] = (f32x4){0.f, 0.f, 0.f, 0.f};
#pragma unroll
        for (int ks = 0; ks < 2; ++ks) { const bf16x8 a = tr_frag(C.lds + G_QE, QS_B, ks, dt, lane);
#pragma unroll
            for (int j = 0; j < 4; ++j) { const bf16x8 bb = tr_frag(C.lds + G_V, VS_B, ks, e0 + j, lane); acc[j] = __builtin_amdgcn_mfma_f32_16x16x32_bf16(a, bb, acc[j], 0, 0, 0); } }
        float* kvp = KV + (size_t)kvidx * (DK * DV);
#pragma unroll
        for (int j = 0; j < 4; ++j)
#pragma unroll
            for (int r = 0; r < 4; ++r) kvp[(16 * dt + 4 * (lane >> 4) + r) * DV + 16 * (e0 + j) + (lane & 15)] = acc[j][r];
    }
    __syncthreads();
}
__device__ __forceinline__ void gla_scan(const Ctx& C) {
    unsigned char* ob = (unsigned char*)ARG_OUT;
    const float* KV = (const float*)(ob + GO_KV); const float* DECAY = (const float*)(ob + GO_DECAY); unsigned* SP = (unsigned*)(ob + GO_SPREV);
    for (int gt = C.gw * 64 + C.lane; gt < BATCH * NH * DK * (DV / 2); gt += C.NGW * 64) {
        const int bh = gt >> 12, d = (gt >> 6) & 63, e2 = gt & 63;
        float s0 = 0.f, s1 = 0.f;
#pragma unroll 8
        for (int n = 0; n < 32; ++n) { const size_t base = (size_t)(bh * 32 + n) * (DK * DV) + d * DV + 2 * e2;
            const float2 kv = *(const float2*)(KV + base); const float dec = DECAY[(size_t)(bh * 32 + n) * DK + d];
            SP[base >> 1] = pk2(s0, s1); s0 = dec * s0 + kv.x; s1 = dec * s1 + kv.y; }
    }
}
__device__ __forceinline__ void gla_pass_c(const Ctx& C) {
    unsigned char* ws = ARG_WS; unsigned char* ob = (unsigned char*)ARG_OUT; const float* gate_up = ARGF(A_GATEUP); const float* gate_bias = ARGF(A_GATEBIAS); const float* norm_g = ARGF(A_NORMG);
    const bf16* PROJ = (const bf16*)(ws + WS_PROJ); const float* GLR = (const float*)(ws + WS_GLR); bf16* YMIX = (bf16*)(ws + WS_H);
    const bf16* SPREV = (const bf16*)(ob + GO_SPREV);
    const int lane = C.lane, w = C.wave, fr = lane & 15, fq = lane >> 4;
    for (int item = C.wg; item < BATCH * 32 * NH; item += C.G) {
        const int hd = item & 3, bn = item >> 2, b = bn >> 5, n = bn & 31, m0 = bn * 64, kvidx = (b * NH + hd) * 32 + n;
        float bc[8], blast;
        gla_stage_prefix<true>(C, PROJ, GLR, SPREV, gate_up, gate_bias, m0, hd, kvidx, bc, blast);
        const int d = C.tid & 63, rb = C.tid >> 6;
#pragma unroll
        for (int i = 0; i < 8; ++i) { const int r = rb * 8 + i; const float kk = bf2f(*(const LAS bf16*)(C.lds + G_K + r * 128 + d * 2)), qq = bf2f(*(const LAS bf16*)(C.lds + G_Q + r * 128 + d * 2));
            *(LAS bf16*)(C.lds + G_QE + r * QS_B + d * 2) = (bf16)f2bf(qq * 0.125f * __expf(bc[i]));
            *(LAS bf16*)(C.lds + G_KE + r * QS_B + d * 2) = (bf16)f2bf(kk * __expf(-bc[i])); }
        __syncthreads();
        {
            const int ct = w >> 1, mt0 = (w & 1) * 2;
            f32x4 at[2] = {(f32x4){0.f, 0.f, 0.f, 0.f}, (f32x4){0.f, 0.f, 0.f, 0.f}};
#pragma unroll
            for (int ks = 0; ks < 2; ++ks) { const bf16x8 a = row_frag(C.lds + G_QE, QS_B, ks, ct, lane);
#pragma unroll
                for (int j = 0; j < 2; ++j) { const bf16x8 bb = row_frag(C.lds + G_KE, QS_B, ks, mt0 + j, lane); at[j] = __builtin_amdgcn_mfma_f32_16x16x32_bf16(a, bb, at[j], 0, 0, 0); } }
#pragma unroll
            for (int j = 0; j < 2; ++j)
#pragma unroll
                for (int r = 0; r < 4; ++r) { const int cc = 16 * ct + 4 * fq + r, mm = 16 * (mt0 + j) + fr; *(LAS bf16*)(C.lds + G_AT + cc * QS_B + mm * 2) = (bf16)f2bf(mm <= cc ? at[j][r] : 0.f); }
        }
        __syncthreads();
        const int ct = w & 3, e0 = (w >> 2) * 4;
        f32x4 acc[4];
#pragma unroll
        for (int j = 0; j < 4; ++j) acc[j] = (f32x4){0.f, 0.f, 0.f, 0.f};
#pragma unroll
        for (int ks = 0; ks < 2; ++ks) { const bf16x8 a = row_frag(C.lds + G_AT, QS_B, ks, ct, lane);
#pragma unroll
            for (int j = 0; j < 4; ++j) { const bf16x8 bb = tr_frag(C.lds + G_V, VS_B, ks, e0 + j, lane); acc[j] = __builtin_amdgcn_mfma_f32_16x16x32_bf16(a, bb, acc[j], 0, 0, 0); } }
#pragma unroll
        for (int ks = 0; ks < 2; ++ks) { const bf16x8 a = row_frag(C.lds + G_QE, QS_B, ks, ct, lane);
#pragma unroll
            for (int j = 0; j < 4; ++j) { const bf16x8 bb = tr_frag(C.lds + G_S, VS_B, ks, e0 + j, lane); acc[j] = __builtin_amdgcn_mfma_f32_16x16x32_bf16(a, bb, acc[j], 0, 0, 0); } }
        float ss[4];
#pragma unroll
        for (int r = 0; r < 4; ++r) { float s = 0.f;
#pragma unroll
            for (int j = 0; j < 4; ++j) s += acc[j][r] * acc[j][r];
            s += __shfl_xor(s, 1); s += __shfl_xor(s, 2); s += __shfl_xor(s, 4); s += __shfl_xor(s, 8); ss[r] = s; }
        if (fr == 0) {
#pragma unroll
            for (int r = 0; r < 4; ++r) ((LAS float*)(C.lds + G_SS))[(16 * ct + 4 * fq + r) * 2 + (w >> 2)] = ss[r]; }
        __syncthreads();
#pragma unroll
        for (int r = 0; r < 4; ++r) { const int cc = 16 * ct + 4 * fq + r; const LAS float* sp = (const LAS float*)(C.lds + G_SS) + cc * 2;
            const float rs = rsqrtf((sp[0] + sp[1]) * (1.f / DV) + RMS_EPS); const size_t m = (size_t)(m0 + cc);
#pragma unroll
            for (int j = 0; j < 4; ++j) { const int e = 16 * (e0 + j) + fr; const float rr = bf2f(PROJ[m * NPROJ + 2560 + hd * DV + e]);
                YMIX[m * D + CONVW + hd * DV + e] = (bf16)f2bf(acc[j][r] * rs * norm_g[hd * DV + e] * silu_f(rr)); } }
    }
    __syncthreads();
}
__device__ __forceinline__ void ln1_phase(const Ctx& C) {
    unsigned char* ws = ARG_WS; const float* x = ARGF(A_X); const float* ln1_g = ARGF(A_LN1G); const float* ln1_b = ARGF(A_LN1B);
    const float* mod = (const float*)(ws + WS_MOD); const float* Y = ARG_OUT; float* X1 = (float*)(ws + WS_X1); bf16* H2 = (bf16*)(ws + WS_H2);
    for (int m = C.gw; m < M; m += C.NGW) {
        const int b = m / SEQ; const float* mrow = mod + b * 6 * D;
        const f32x4* g1 = (const f32x4*)(mrow + 2 * D) + C.lane; const f32x4* sh2 = (const f32x4*)(mrow + 3 * D) + C.lane; const f32x4* sc2 = (const f32x4*)(mrow + 4 * D) + C.lane;
        const f32x4* xr = (const f32x4*)(x + (size_t)m * D) + C.lane; const f32x4* yr = (const f32x4*)(Y + (size_t)m * D) + C.lane;
        f32x4 v[4]; float s = 0.f;
#pragma unroll
        for (int j = 0; j < 4; ++j) { v[j] = xr[64 * j] * ALPHA + (g1[64 * j] + 1.0f) * yr[64 * j]; s += (v[j].x + v[j].y) + (v[j].z + v[j].w); }
        const float mean = wave_sum(s) * (1.f / D); float q = 0.f;
#pragma unroll
        for (int j = 0; j < 4; ++j) { v[j] = v[j] - mean; q += (v[j].x * v[j].x + v[j].y * v[j].y) + (v[j].z * v[j].z + v[j].w * v[j].w); }
        const float rstd = rsqrtf(wave_sum(q) * (1.f / D) + LN_EPS);
        f32x4* xo = (f32x4*)(X1 + (size_t)m * D) + C.lane; unsigned long long* ho = (unsigned long long*)(H2 + (size_t)m * D) + C.lane;
#pragma unroll
        for (int j = 0; j < 4; ++j) { const f32x4 x1 = v[j] * rstd * ((const f32x4*)ln1_g)[C.lane + 64 * j] + ((const f32x4*)ln1_b)[C.lane + 64 * j]; xo[64 * j] = x1;
            const f32x4 h2 = x1 * (sc2[64 * j] + 1.0f) + sh2[64 * j]; ho[64 * j] = (unsigned long long)pk2(h2.x, h2.y) | ((unsigned long long)pk2(h2.z, h2.w) << 32); }
    }
}
__device__ __forceinline__ int fkey(float f) { const int b = __builtin_bit_cast(int, f); return b ^ ((b >> 31) & 0x7fffffff); }
__device__ __forceinline__ float kfloat(int k) { const int b = k ^ ((k >> 31) & 0x7fffffff); return __builtin_bit_cast(float, b); }
template <int N> __device__ __forceinline__ void sort16_groups_desc(int (&v)[N]) {
#pragma unroll
    for (int ks = 1; ks <= 4; ++ks)
#pragma unroll
        for (int js = ks - 1; js >= 0; --js)
#pragma unroll
            for (int i = 0; i < N; ++i) { const int k = 1 << ks, j = 1 << js, l = i ^ j;
                if (l > i) { const bool desc = ((i & 15 & k) == 0); const int mx = max(v[i], v[l]), mn = min(v[i], v[l]); v[i] = desc ? mx : mn; v[l] = desc ? mn : mx; } }
}
template <int OA, int OB, int N> __device__ __forceinline__ void merge_top16(int (&v)[N]) {
#pragma unroll
    for (int i = 0; i < 16; ++i) v[OA + i] = max(v[OA + i], v[OB + 15 - i]);
#pragma unroll
    for (int js = 3; js >= 0; --js)
#pragma unroll
        for (int i = 0; i < 16; ++i) { const int j = 1 << js, l = i ^ j; if (l > i) { const int mx = max(v[OA + i], v[OA + l]), mn = min(v[OA + i], v[OA + l]); v[OA + i] = mx; v[OA + l] = mn; } }
}
__device__ __forceinline__ void top16_of_64(int (&v)[64]) { sort16_groups_desc<64>(v); merge_top16<0, 16, 64>(v); merge_top16<32, 48, 64>(v); merge_top16<0, 32, 64>(v); }
constexpr int cand_n(int a) { return a == 0 ? 16 : 16 / (a + 1); }
constexpr int cand_off(int a) { int s = 0; for (int i = 0; i < a; ++i) s += cand_n(i); return s; }
static_assert(cand_off(16) == 50, "staircase candidate count");

__device__ __forceinline__ void route_item(const bf16* Q, const bf16* SUBK, int* IDX, float* GATE, int tg, int h, LAS unsigned char* slot, int lane) {
    const int col = lane & 31, hi = lane >> 5, t = tg * 32 + col;
    LAS int* tl = (LAS int*)slot + lane;
#pragma unroll 1
    for (int p = 0; p < 2; ++p) {
        f32x16 acc[4];
#pragma unroll
        for (int kt = 0; kt < 4; ++kt)
#pragma unroll
            for (int r = 0; r < 16; ++r) acc[kt][r] = 0.f;
        const bf16* qrow = Q + (size_t)t * NQ + h * 256 + p * 128 + 8 * hi;
        const bf16* kb = SUBK + ((size_t)(h * 2 + p) * NKEYS + col) * 128 + 8 * hi;
#pragma unroll
        for (int ks = 0; ks < 8; ++ks) { const bf16x8 bq = *(const bf16x8*)(qrow + ks * 16);
#pragma unroll
            for (int kt = 0; kt < 4; ++kt) { const bf16x8 ak = *(const bf16x8*)(kb + (size_t)kt * 32 * 128 + ks * 16); acc[kt] = __builtin_amdgcn_mfma_f32_32x32x16_bf16(ak, bq, acc[kt], 0, 0, 0); } }
        int v[64];
#pragma unroll
        for (int kt = 0; kt < 4; ++kt)
#pragma unroll
            for (int r = 0; r < 16; ++r) { const int n = kt * 32 + 8 * (r >> 2) + (r & 3) + 4 * hi; v[kt * 16 + r] = (fkey(acc[kt][r]) & ~0x7F) | n; }
        top16_of_64(v);
#pragma unroll
        for (int i = 0; i < 16; ++i) v[16 + i] = __shfl_xor(v[i], 32);
        merge_top16<0, 16, 64>(v);
#pragma unroll
        for (int i = 0; i < 16; ++i) tl[(p * 16 + i) * 64] = v[i];
    }
    int c[64];
    {
        float s1[16], s2[16];
#pragma unroll
        for (int i = 0; i < 16; ++i) { s1[i] = kfloat(tl[i * 64] & ~0x7F); s2[i] = kfloat(tl[(16 + i) * 64] & ~0x7F); }
#pragma unroll
        for (int a = 0; a < 16; ++a)
#pragma unroll
            for (int b = 0; b < 16; ++b) if (b < cand_n(a)) c[cand_off(a) + b] = (fkey(s1[a] + s2[b]) & ~0xFF) | (a * 16 + b);
    }
#pragma unroll
    for (int i = 50; i < 64; ++i) c[i] = (int)0x80000000;
    top16_of_64(c);
    const float mx = kfloat(c[0] & ~0xFF);
    float ev[16]; float sum = 0.f; int id[16];
#pragma unroll
    for (int i = 0; i < 16; ++i) { ev[i] = __expf(kfloat(c[i] & ~0xFF) - mx); sum += ev[i]; const int ab = c[i] & 0xFF; id[i] = (tl[(ab >> 4) * 64] & 0x7F) * NKEYS + (tl[(16 + (ab & 15)) * 64] & 0x7F); }
    const float inv = 1.f / sum;
    if (hi == 0) { int* dst = IDX + ((size_t)t * PH + h) * TOPK;
#pragma unroll
        for (int q4 = 0; q4 < 4; ++q4) { v4u o; o.x = (unsigned)id[4 * q4]; o.y = (unsigned)id[4 * q4 + 1]; o.z = (unsigned)id[4 * q4 + 2]; o.w = (unsigned)id[4 * q4 + 3]; *(v4u*)(dst + 4 * q4) = o; }
    } else { float* dst = GATE + ((size_t)t * PH + h) * TOPK;
#pragma unroll
        for (int q4 = 0; q4 < 4; ++q4) { f32x4 o; o.x = ev[4 * q4] * inv; o.y = ev[4 * q4 + 1] * inv; o.z = ev[4 * q4 + 2] * inv; o.w = ev[4 * q4 + 3] * inv; *(f32x4*)(dst + 4 * q4) = o; }
    }
}
__device__ __forceinline__ void route_phase(const Ctx& C) {
    unsigned char* ws = ARG_WS;
    const bf16* Q = (const bf16*)ARG_OUT; const bf16* SUBK = (const bf16*)(ws + WS_SUBK); int* IDX = (int*)(ws + WS_IDX); float* GATE = (float*)(ws + WS_GATE);
    for (int item = C.gw; item < (M / 32) * PH; item += C.NGW) route_item(Q, SUBK, IDX, GATE, item >> 3, item & 7, C.lds + C.wave * 8192, C.lane);
}
__device__ __forceinline__ void unpack8(const v4u p, float* f) { f[0] = bflo(p.x); f[1] = bfhi(p.x); f[2] = bflo(p.y); f[3] = bfhi(p.y); f[4] = bflo(p.z); f[5] = bfhi(p.z); f[6] = bflo(p.w); f[7] = bfhi(p.w); }
#define PEER_GROUP(idreg, greg, jbase)                                                                                         \
    {                                                                                                                          \
        int e_[4]; float gg_[4]; v4u ua_[4], ub_[4];                                                                           \
        _Pragma("unroll") for (int i = 0; i < 4; ++i) { e_[i] = __builtin_amdgcn_readlane(idreg, (jbase) + i); gg_[i] = __builtin_bit_cast(float, __builtin_amdgcn_readlane(__builtin_bit_cast(int, greg), (jbase) + i)); } \
        _Pragma("unroll") for (int i = 0; i < 4; ++i) { const bf16* ur = PU + (size_t)e_[i] * D + lane * 8; ua_[i] = *(const v4u*)ur; ub_[i] = *(const v4u*)(ur + 512); }                                              \
        v4u va_[4], vb_[4];                                                                                                    \
        _Pragma("unroll") for (int i = 0; i < 4; ++i) { const bf16* vr = PV + (size_t)e_[i] * D + lane * 8; va_[i] = *(const v4u*)vr; vb_[i] = *(const v4u*)(vr + 512); }                                              \
        float dt_[4];                                                                                                          \
        _Pragma("unroll") for (int i = 0; i < 4; ++i) { float f_[16]; unpack8(ua_[i], f_); unpack8(ub_[i], f_ + 8); float s_ = 0.f;                                                                                    \
            _Pragma("unroll") for (int k = 0; k < 16; ++k) s_ += f_[k] * hv[k]; dt_[i] = s_; }                                 \
        _Pragma("unroll") for (int o = 1; o < 64; o <<= 1) { _Pragma("unroll") for (int i = 0; i < 4; ++i) dt_[i] += __shfl_xor(dt_[i], o); }                                                                          \
        _Pragma("unroll") for (int i = 0; i < 4; ++i) { const float a_ = gelu_f(dt_[i]) * gg_[i]; float f_[16]; unpack8(va_[i], f_); unpack8(vb_[i], f_ + 8);                                                         \
            _Pragma("unroll") for (int k = 0; k < 16; ++k) acc[k] += a_ * f_[k]; }                                             \
    }
__device__ __forceinline__ void peer_phase(const Ctx& C) {
    unsigned char* ws = ARG_WS; float* out = ARG_OUT; const float* ln2_g = ARGF(A_LN2G); const float* ln2_b = ARGF(A_LN2B);
    const float* mod = (const float*)(ws + WS_MOD); const bf16* H2 = (const bf16*)(ws + WS_H2); const bf16* PU = (const bf16*)(ws + WS_PU); const bf16* PV = (const bf16*)(ws + WS_PV);
    const int* IDX = (const int*)(ws + WS_IDX); const float* GATE = (const float*)(ws + WS_GATE); const float* X1 = (const float*)(ws + WS_X1);
    const int lane = C.lane;
    for (int t = C.gw; t < M; t += C.NGW) {
        const int b = t / SEQ; const float* mrow = mod + b * 6 * D;
        float hv[16];
        { const v4u p0 = *(const v4u*)(H2 + (size_t)t * D + lane * 8), p1 = *(const v4u*)(H2 + (size_t)t * D + 512 + lane * 8); unpack8(p0, hv); unpack8(p1, hv + 8); }
        const int id0 = IDX[(size_t)t * 128 + lane], id1 = IDX[(size_t)t * 128 + 64 + lane];
        const float g0 = GATE[(size_t)t * 128 + lane], g1 = GATE[(size_t)t * 128 + 64 + lane];
        float acc[16];
#pragma unroll
        for (int k = 0; k < 16; ++k) acc[k] = 0.f;
        for (int jb = 0; jb < 64; jb += 4) PEER_GROUP(id0, g0, jb)
        for (int jb = 0; jb < 64; jb += 4) PEER_GROUP(id1, g1, jb)
        float v[16]; float s = 0.f;
#pragma unroll
        for (int hb = 0; hb < 2; ++hb)
#pragma unroll
            for (int q4 = 0; q4 < 2; ++q4) { const int cidx = hb * 512 + lane * 8 + q4 * 4; const f32x4 xv = *(const f32x4*)(X1 + (size_t)t * D + cidx); const f32x4 g2 = *(const f32x4*)(mrow + 5 * D + cidx);
                const int k = hb * 8 + q4 * 4;
                v[k] = ALPHA * xv.x + (1.f + g2.x) * acc[k]; v[k + 1] = ALPHA * xv.y + (1.f + g2.y) * acc[k + 1]; v[k + 2] = ALPHA * xv.z + (1.f + g2.z) * acc[k + 2]; v[k + 3] = ALPHA * xv.w + (1.f + g2.w) * acc[k + 3];
                s += (v[k] + v[k + 1]) + (v[k + 2] + v[k + 3]); }
        const float mean = wave_sum(s) * (1.f / D); float q = 0.f;
#pragma unroll
        for (int k = 0; k < 16; ++k) { v[k] -= mean; q += v[k] * v[k]; }
        const float rstd = rsqrtf(wave_sum(q) * (1.f / D) + LN_EPS);
#pragma unroll
        for (int hb = 0; hb < 2; ++hb)
#pragma unroll
            for (int q4 = 0; q4 < 2; ++q4) { const int cidx = hb * 512 + lane * 8 + q4 * 4; const f32x4 gg = *(const f32x4*)(ln2_g + cidx), bb = *(const f32x4*)(ln2_b + cidx); const int k = hb * 8 + q4 * 4;
                f32x4 o; o.x = v[k] * rstd * gg.x + bb.x; o.y = v[k + 1] * rstd * gg.y + bb.y; o.z = v[k + 2] * rstd * gg.z + bb.z; o.w = v[k + 3] * rstd * gg.w + bb.w;
                *(f32x4*)(out + (size_t)t * D + cidx) = o; }
    }
}
#ifndef MK_N_LAUNCHES
#define MK_N_LAUNCHES 1
#endif
constexpr int NPH = 11;
constexpr int N_LAUNCHES = MK_N_LAUNCHES;
static_assert(N_LAUNCHES == 1 || N_LAUNCHES == NPH, "MK_N_LAUNCHES is 1 or NPH");

struct Args { const float* in[18]; float* out; unsigned char* ws; int ph_lo, ph_hi; };

__global__ void __launch_bounds__(NTHR, 2) mk_fwd(Args args) {
    extern __shared__ __attribute__((aligned(16))) unsigned char lds_raw[];
    Ctx C;
    C.lds = (LAS unsigned char*)lds_raw;
    C.tid = threadIdx.x; C.lane = C.tid & 63; C.wave = __builtin_amdgcn_readfirstlane(C.tid >> 6);
    C.wg = blockIdx.x; C.G = gridDim.x; C.gw = C.wg * NWAVES + C.wave; C.NGW = C.G * NWAVES;
    volatile LAS unsigned* MISC = (volatile LAS unsigned*)(C.lds + MISC_OFF);
    for (int u = C.tid; u < (LDS_BYTES - LDSCTL_OFF) / 4; u += NTHR) ((LAS unsigned*)(C.lds + LDSCTL_OFF))[u] = 0u;
    __syncthreads();
    if (C.tid < A_COUNT) {
        const unsigned long long v = (C.tid < 18) ? (unsigned long long)args.in[C.tid < 18 ? C.tid : 0] : (C.tid == A_OUT ? (unsigned long long)args.out : (unsigned long long)args.ws);
        ((LAS unsigned long long*)(C.lds + ARGT_OFF))[C.tid] = v;
    }
    __syncthreads();
    unsigned* ctl = (unsigned*)(ARG_WS + WS_CTL);
    XcdBarrier bar; bar.bar = ctl + CW_BAR; bar.x = 0; bar.st = nullptr;
    if (N_LAUNCHES == 1) bar = xcd_barrier_post(ctl + CW_BAR, MISC + 8);
    const int lo = args.ph_lo, hi = args.ph_hi;
#define IN(k) (lo <= (k) && (k) < hi)
#define SEAM(k) do { if (IN(k) && IN((k) + 1)) xcd_barrier(bar); } while (0)

    if (IN(0)) { phase0(C); } SEAM(0);
    if (IN(1)) { phase0b(C); } SEAM(1);
    if (IN(2)) {
        pg8::Gemm g{(const pg8::bf16_t*)(ARG_WS + WS_H), (const pg8::bf16_t*)(ARG_WS + WS_WIN), M, NPROJ, D}; pg8::StaticOrder S; S.init(M, NPROJ, C.G, C.wg);
        pg8::EpiBf16<0> E{(pg8::bf16_t*)(ARG_WS + WS_PROJ), NPROJ, nullptr, 0, 0, 1.f};
        pg8::gemm_phase<pg8::EpiBf16<0>, pg8::StaticOrder, true, true>(C.lds, g, S, E);
        glr_simple(C);
    } SEAM(2);
    if (IN(3)) { conv_phase(C); gla_pass_a(C); } SEAM(3);
    if (IN(4)) { gla_scan(C); } SEAM(4);
    if (IN(5)) { gla_pass_c(C); } SEAM(5);
    if (IN(6)) {
        pg8::Gemm g{(const pg8::bf16_t*)(ARG_WS + WS_H), (const pg8::bf16_t*)(ARG_WS + WS_WOUT), M, D, D}; pg8::StaticOrder S; S.init(M, D, C.G, C.wg);
        EpiF32 E{ARG_OUT, D};
        pg8::gemm_phase<EpiF32, pg8::StaticOrder, true, true>(C.lds, g, S, E);
    } SEAM(6);
    if (IN(7)) { ln1_phase(C); } SEAM(7);
    if (IN(8)) {
        pg8::Gemm g{(const pg8::bf16_t*)(ARG_WS + WS_H2), (const pg8::bf16_t*)(ARG_WS + WS_WQ), M, NQ, D}; pg8::StaticOrder S; S.init(M, NQ, C.G, C.wg);
        pg8::EpiBf16<0> E{(pg8::bf16_t*)ARG_OUT, NQ, nullptr, 0, 0, 1.f};
        pg8::gemm_phase<pg8::EpiBf16<0>, pg8::StaticOrder, true, true>(C.lds, g, S, E);
    } SEAM(8);
    if (IN(9)) { route_phase(C); } SEAM(9);
    if (IN(10)) { peer_phase(C); }
#undef IN
#undef SEAM
}

extern "C" void kernel_launch(void* const* d_in, const int* in_sizes, int n_in, void* d_out, int out_size, void* d_ws, size_t ws_size, hipStream_t stream) {
    static int grid = 0;
    if (grid == 0) {
        int dev = 0, cus = 0;
        if (n_in != 18 || out_size != M * D || ws_size < 256 * MiB) { fprintf(stderr, "kernel_launch: unexpected problem (n_in %d out %d ws %zu)\n", n_in, out_size, ws_size); grid = -1; return; }
        if (hipGetDevice(&dev) != hipSuccess || hipDeviceGetAttribute(&cus, hipDeviceAttributeMultiprocessorCount, dev) != hipSuccess) { grid = -1; return; }
        if (hipFuncSetAttribute((const void*)mk_fwd, hipFuncAttributeMaxDynamicSharedMemorySize, LDS_BYTES) != hipSuccess) { fprintf(stderr, "kernel_launch: hipFuncSetAttribute failed\n"); grid = -1; return; }
        int per_cu = 0;
        (void)hipOccupancyMaxActiveBlocksPerMultiprocessor(&per_cu, (const void*)mk_fwd, NTHR, LDS_BYTES);
        (void)hipGetLastError();
        if (per_cu < 1) fprintf(stderr, "kernel_launch: occupancy query reports %d blocks per CU\n", per_cu);
        grid = cus;
    }
    if (grid < 0) return;
    (void)hipMemsetAsync((char*)d_ws + WS_CTL, 0, CTL_ZERO_BYTES, stream);
    Args a{};
    for (int i = 0; i < 18; ++i) a.in[i] = (const float*)d_in[i];
    a.out = (float*)d_out; a.ws = (unsigned char*)d_ws;
    for (int li = 0; li < N_LAUNCHES; ++li) {
        a.ph_lo = (N_LAUNCHES == 1) ? 0 : li; a.ph_hi = (N_LAUNCHES == 1) ? NPH : li + 1;
        hipLaunchKernelGGL(mk_fwd, dim3(grid), dim3(NTHR), LDS_BYTES, stream, a);
    }
}
```

```cpp
#include <hip/hip_runtime.h>
#include <cstdio>
#include <cstdint>
#include <cmath>
namespace pg8 {
#define PG8_LAS __attribute__((address_space(3)))
typedef unsigned short bf16_t;
typedef short bf16x8 __attribute__((ext_vector_type(8)));
typedef float f32x4 __attribute__((ext_vector_type(4)));
typedef unsigned u32x4 __attribute__((ext_vector_type(4)));
constexpr int BM = 256, BK = 64, HALF = 128, HTB = HALF * BK * 2  , STAGE_BYTES = 8 * HTB, NXCD = 8, WGM = 8;

__host__ __device__ __forceinline__ int lds_byte(int r, int c) { const int st = (r >> 4) * 2 + (c >> 5), rr = r & 15, cc = c & 31, ob = rr * 64 + cc * 2; return st * 1024 + (ob ^ (((ob >> 9) & 1) << 5)); }
__host__ __device__ __forceinline__ void stage_rc(int b, int& R, int& C) { const int st = b / 1024, sb = b % 1024, swz = sb ^ (((sb >> 9) & 1) << 5); R = (st >> 1) * 16 + swz / 64; C = (st & 1) * 32 + (swz % 64) / 2; }
__host__ __device__ __forceinline__ int perm32(int rho) { const int n = rho >> 4, i = rho & 15; return 8 * (i >> 2) + 4 * n + (i & 3); }

struct Unit { int pm, pn; };
struct Gemm { const bf16_t* A; const bf16_t* Bt; int M, N, K; };

struct StaticOrder {
    int nM, nN, nwg, G, c;
    __host__ __device__ void init(int M, int N, int G_, int c_) { nM = M / BM; nN = N / BM; nwg = nM * nN; G = G_; c = c_; }
    __host__ __device__ bool next(int i, Unit& u) const {
        const long L = (long)i * G + c; if (L >= nwg) return false;
        int wgid = (int)L; { const int q = nwg / NXCD, r = nwg % NXCD, xcd = wgid % NXCD, off = wgid / NXCD; wgid = (xcd < r ? xcd * (q + 1) : r * (q + 1) + (xcd - r) * q) + off; }
        const int nig = WGM * nN, gid = wgid / nig, fm = gid * WGM, gsz = (nM - fm) < WGM ? (nM - fm) : WGM;
        u.pm = fm + ((wgid % nig) % gsz); u.pn = (wgid % nig) / gsz; return true;
    }
    __device__ __forceinline__ void a_ready(const Unit&) const {}
    __device__ __forceinline__ void done(const Unit&) const {}
};

__device__ __forceinline__ unsigned cvt_pk_bf16(float lo, float hi) { unsigned r; asm volatile("v_cvt_pk_bf16_f32 %0, %1, %2" : "=v"(r) : "v"(lo), "v"(hi)); return r; }
typedef float f32x2 __attribute__((ext_vector_type(2)));
__device__ __forceinline__ f32x2 gelu_pk(f32x2 v) {
    const f32x2 av = __builtin_elementwise_abs(v), d = av * 0.2316418882f + 1.0f;
    f32x2 t; t.x = __builtin_amdgcn_rcpf(d.x); t.y = __builtin_amdgcn_rcpf(d.y);
    f32x2 q = t * 0.5307027145f + (-0.7265760135f); q = q * t + 0.7107068705f; q = q * t + (-0.142248368f); q = q * t + 0.127414796f; q = q * t;
    const f32x2 s = (v * v) * (-0.72134752044f);
    f32x2 e; e.x = __builtin_amdgcn_exp2f(s.x); e.y = __builtin_amdgcn_exp2f(s.y);
    const f32x2 m = v * (q * e), r = v - m;
    f32x2 o; o.x = v.x < 0.f ? m.x : r.x; o.y = v.y < 0.f ? m.y : r.y; return o;
}

template <int ACT  > struct EpiBf16 {
    static constexpr bool PERM = true, AFTER_DRAIN = false; static_assert(ACT == 0 || ACT == 1, "EpiBf16: ACT is 0 (none) or 1 (gelu_pk)");
    bf16_t* O; int ldc; const float* bias; int split_cols; size_t split_stride; float scale0;
    __device__ __forceinline__ void operator()(const f32x4 (&acc)[2][2][4][2], const Unit& u, int wr, int wc, int fr, int fq) const {
        const int row0 = u.pm * BM + wr * 64 + fr; int colt = u.pn * BM; bf16_t* base = O;
        float sc = 1.f; if (split_cols) { const int t = colt / split_cols; base += (size_t)t * split_stride; colt -= t * split_cols; if (t == 0) sc = scale0; }
        const int col0 = colt + wc * 32 + 8 * fq, bcol0 = u.pn * BM + wc * 32 + 8 * fq;
        f32x4 bv[2][2];
#pragma unroll
        for (int bj = 0; bj < 2; ++bj)
#pragma unroll
            for (int n = 0; n < 2; ++n) bv[bj][n] = bias ? *(const f32x4*)(bias + bcol0 + bj * HALF + 4 * n) : (f32x4){0.f, 0.f, 0.f, 0.f};
#pragma unroll
        for (int ai = 0; ai < 2; ++ai)
#pragma unroll
            for (int m = 0; m < 4; ++m) { bf16_t* rowp = base + (size_t)(row0 + ai * HALF + m * 16) * ldc + col0;
#pragma unroll
                for (int bj = 0; bj < 2; ++bj) { f32x4 v0 = acc[ai][bj][m][0] + bv[bj][0], v1 = acc[ai][bj][m][1] + bv[bj][1];
                    if (ACT == 1) { f32x2 a = gelu_pk((f32x2){v0[0], v0[1]}), b = gelu_pk((f32x2){v0[2], v0[3]}), c = gelu_pk((f32x2){v1[0], v1[1]}), d = gelu_pk((f32x2){v1[2], v1[3]});
                        v0 = (f32x4){a.x, a.y, b.x, b.y}; v1 = (f32x4){c.x, c.y, d.x, d.y}; }
                    v0 = v0 * sc; v1 = v1 * sc; u32x4 w; w.x = cvt_pk_bf16(v0[0], v0[1]); w.y = cvt_pk_bf16(v0[2], v0[3]); w.z = cvt_pk_bf16(v1[0], v1[1]); w.w = cvt_pk_bf16(v1[2], v1[3]);
                    *(u32x4*)(rowp + bj * HALF) = w; } }
    }
};

struct PanelStats {
    unsigned* xbuf;
    unsigned* cnt;
    unsigned* tmo;
    int ntn; float eps;
    unsigned code;
    __device__ __forceinline__ bool run(const f32x4 (&v)[2][2][4][2], const Unit& u, int wr, int wc, int fr, int fq, PG8_LAS unsigned char* lds, int wid, int lane) const {
        typedef float f32x2v __attribute__((ext_vector_type(2)));
        PG8_LAS f32x2v* P = (PG8_LAS f32x2v*)lds;
        PG8_LAS f32x2v* S = (PG8_LAS f32x2v*)(lds + 8192);
        PG8_LAS unsigned* flag = (PG8_LAS unsigned*)(lds + 8192 + 2048);
#pragma unroll
        for (int ai = 0; ai < 2; ++ai)
#pragma unroll
            for (int m = 0; m < 4; ++m) {
                float s = 0.f;
#pragma unroll
                for (int bj = 0; bj < 2; ++bj)
#pragma unroll
                    for (int n = 0; n < 2; ++n) { const f32x4 x = v[ai][bj][m][n]; s += (x[0] + x[1]) + (x[2] + x[3]); }
                s += __shfl_xor(s, 16); s += __shfl_xor(s, 32);
                const float mw = s * (1.0f / 64.0f); float q = 0.f;
#pragma unroll
                for (int bj = 0; bj < 2; ++bj)
#pragma unroll
                    for (int n = 0; n < 2; ++n) { const f32x4 d = v[ai][bj][m][n] - mw; q += (d[0] * d[0] + d[1] * d[1]) + (d[2] * d[2] + d[3] * d[3]); }
                q += __shfl_xor(q, 16); q += __shfl_xor(q, 32);
                if (fq == 0) P[(ai * HALF + wr * 64 + m * 16 + fr) * 4 + wc] = (f32x2v){mw, q};
            }
        asm volatile("s_waitcnt lgkmcnt(0)" ::: "memory"); __builtin_amdgcn_s_barrier(); asm volatile("" ::: "memory");
#if defined(BROKEN_EXCHANGE_NO_WAIT)
#warning BROKEN CONTROL BUILD: the row-statistics exchange does not wait; results are wrong by design
        if (blockIdx.x >= 64) { const long long t0_ = clock64(); while (clock64() - t0_ < 60000) __builtin_amdgcn_s_sleep(8); }
#endif
        const int row = wid * 32 + (lane & 31);
        if (lane < 32) {
            const f32x2v a = P[row * 4 + 0], b = P[row * 4 + 1], c = P[row * 4 + 2], d = P[row * 4 + 3];
            const float mt = (a.x + b.x + c.x + d.x) * 0.25f;
            const float da = a.x - mt, db = b.x - mt, dc = c.x - mt, dd = d.x - mt;
            const float m2 = (a.y + b.y) + (c.y + d.y) + 64.0f * ((da * da + db * db) + (dc * dc + dd * dd));
            unsigned long long* slot = (unsigned long long*)xbuf + ((size_t)(u.pm * BM + row) * 4 + u.pn);
            __hip_atomic_store(slot, ((unsigned long long)__float_as_uint(m2) << 32) | __float_as_uint(mt), __ATOMIC_RELAXED, __HIP_MEMORY_SCOPE_AGENT);
        }
        asm volatile("s_waitcnt vmcnt(0)" ::: "memory");
        if (lane == 0) __hip_atomic_fetch_add(cnt + 64 * u.pm, 1u, __ATOMIC_RELAXED, __HIP_MEMORY_SCOPE_AGENT);
        if (wid == 0) {
            bool dead = false; const unsigned long long t0 = __builtin_amdgcn_s_memrealtime(); const unsigned want = 8u * (unsigned)ntn;
            for (;;) {
#if defined(BROKEN_EXCHANGE_NO_WAIT)
                break;
#endif
                if ((unsigned)__builtin_amdgcn_readfirstlane(__hip_atomic_load(cnt + 64 * u.pm, __ATOMIC_RELAXED, __HIP_MEMORY_SCOPE_AGENT)) >= want) break;
                if (__builtin_amdgcn_s_memrealtime() - t0 > 2000000ull) {
                    if (lane == 0) { unsigned expect = 0u; __hip_atomic_compare_exchange_strong(tmo + 1, &expect, code | (unsigned)(u.pm & 0xff), __ATOMIC_RELAXED, __ATOMIC_RELAXED, __HIP_MEMORY_SCOPE_AGENT);
                                     __hip_atomic_store(tmo, 1u, __ATOMIC_RELAXED, __HIP_MEMORY_SCOPE_AGENT); }
                    dead = true; break; }
                __builtin_amdgcn_s_sleep(2);
            }
            __builtin_amdgcn_fence(__ATOMIC_ACQUIRE, "agent");
            if (lane == 0) flag[0] = dead ? 1u : 0u;
        }
        asm volatile("s_waitcnt vmcnt(0) lgkmcnt(0)" ::: "memory"); __builtin_amdgcn_s_barrier(); asm volatile("" ::: "memory");
        const bool bad = flag[0] != 0u;
        if (lane < 32) {
            const unsigned long long* slot = (const unsigned long long*)xbuf + (size_t)(u.pm * BM + row) * 4; float mt[4], m2[4]; float ms = 0.f;
#pragma unroll
            for (int t = 0; t < 4; ++t) { if (t < ntn) { const unsigned long long w = __hip_atomic_load(slot + t, __ATOMIC_RELAXED, __HIP_MEMORY_SCOPE_AGENT); mt[t] = __uint_as_float((unsigned)w); m2[t] = __uint_as_float((unsigned)(w >> 32)); } else { mt[t] = 0.f; m2[t] = 0.f; } ms += mt[t]; }
            const float mean = ms / (float)ntn; float q = 0.f;
#pragma unroll
            for (int t = 0; t < 4; ++t) if (t < ntn) { const float dm = mt[t] - mean; q += m2[t] + 256.0f * dm * dm; }
            S[row] = (f32x2v){mean, 1.0f / sqrtf(q / (256.0f * (float)ntn) + eps)};
        }
        asm volatile("s_waitcnt lgkmcnt(0)" ::: "memory"); __builtin_amdgcn_s_barrier(); asm volatile("" ::: "memory");
        return bad;
    }
};
struct EpiLnRes {
    static constexpr bool PERM = false, AFTER_DRAIN = true;
    const float* base; float* out; int ldc; const float* bias; PanelStats st; unsigned poison;
    __device__ __forceinline__ void fused(f32x4 (&acc)[2][2][4][2], const Unit& u, int wr, int wc, int fr, int fq, PG8_LAS unsigned char* lds, int wid, int lane) const {
        typedef float f32x2v __attribute__((ext_vector_type(2)));
        const PG8_LAS f32x2v* S = (const PG8_LAS f32x2v*)(lds + 8192);
        const int col0 = u.pn * BM + wc * 32 + 4 * fq;
#pragma unroll
        for (int bj = 0; bj < 2; ++bj)
#pragma unroll
            for (int n = 0; n < 2; ++n) { const f32x4 bv = bias ? *(const f32x4*)(bias + col0 + bj * HALF + n * 16) : (f32x4){0.f, 0.f, 0.f, 0.f};
#pragma unroll
                for (int ai = 0; ai < 2; ++ai)
#pragma unroll
                    for (int m = 0; m < 4; ++m) acc[ai][bj][m][n] += bv; }
        f32x4 pre[4][2][2];
#pragma unroll
        for (int m = 0; m < 4; ++m) { const size_t off = (size_t)(u.pm * BM + wr * 64 + m * 16 + fr) * ldc + col0;
#pragma unroll
            for (int bj = 0; bj < 2; ++bj)
#pragma unroll
                for (int n = 0; n < 2; ++n) pre[m][bj][n] = *(const f32x4*)(base + off + bj * HALF + n * 16); }
        const bool bad = st.run(acc, u, wr, wc, fr, fq, lds, wid, lane) || poison != 0u;
        const float qnan = __builtin_nanf("");
#pragma unroll
        for (int ai = 0; ai < 2; ++ai)
#pragma unroll
            for (int m = 0; m < 4; ++m) { const int r = ai * HALF + wr * 64 + m * 16 + fr; const f32x2v sr = S[r]; const size_t off = (size_t)(u.pm * BM + r) * ldc + col0;
#pragma unroll
                for (int bj = 0; bj < 2; ++bj)
#pragma unroll
                    for (int n = 0; n < 2; ++n) { const f32x4 bs = ai == 0 ? pre[m][bj][n] : *(const f32x4*)(base + off + bj * HALF + n * 16); f32x4 o = bs + (acc[ai][bj][m][n] - sr.x) * sr.y;
                        if (bad) o = (f32x4){qnan, qnan, qnan, qnan}; *(f32x4*)(out + off + bj * HALF + n * 16) = o; }
                if (m & 1) asm volatile("" ::: "memory"); }
    }
};
struct EpiLnResLn {
    static constexpr bool PERM = false, AFTER_DRAIN = true;
    const float* base; float* out; bf16_t* xn; int ldc; const float* bias; PanelStats st1, st2; unsigned poison;
    __device__ __forceinline__ void fused(f32x4 (&acc)[2][2][4][2], const Unit& u, int wr, int wc, int fr, int fq, PG8_LAS unsigned char* lds, int wid, int lane) const {
        typedef float f32x2v __attribute__((ext_vector_type(2))); typedef unsigned u32x2v __attribute__((ext_vector_type(2)));
        const PG8_LAS f32x2v* S = (const PG8_LAS f32x2v*)(lds + 8192);
        const int col0 = u.pn * BM + wc * 32 + 4 * fq;
#pragma unroll
        for (int bj = 0; bj < 2; ++bj)
#pragma unroll
            for (int n = 0; n < 2; ++n) { const f32x4 bv = bias ? *(const f32x4*)(bias + col0 + bj * HALF + n * 16) : (f32x4){0.f, 0.f, 0.f, 0.f};
#pragma unroll
                for (int ai = 0; ai < 2; ++ai)
#pragma unroll
                    for (int m = 0; m < 4; ++m) acc[ai][bj][m][n] += bv; }
        bool bad = st1.run(acc, u, wr, wc, fr, fq, lds, wid, lane) || poison != 0u;
        const float qnan = __builtin_nanf("");
#pragma unroll
        for (int ai = 0; ai < 2; ++ai)
#pragma unroll
            for (int m = 0; m < 4; ++m) { const int r = ai * HALF + wr * 64 + m * 16 + fr; const f32x2v sr = S[r]; const size_t off = (size_t)(u.pm * BM + r) * ldc + col0;
#pragma unroll
                for (int bj = 0; bj < 2; ++bj)
#pragma unroll
                    for (int n = 0; n < 2; ++n) { const f32x4 bs = *(const f32x4*)(base + off + bj * HALF + n * 16); acc[ai][bj][m][n] = bs + (acc[ai][bj][m][n] - sr.x) * sr.y; }
                asm volatile("" : "+v"(acc[ai][0][m][0]), "+v"(acc[ai][0][m][1]), "+v"(acc[ai][1][m][0]), "+v"(acc[ai][1][m][1]));
                if (m & 1) asm volatile("" ::: "memory"); }
        const bool bad1 = bad;
        bad = st2.run(acc, u, wr, wc, fr, fq, lds, wid, lane) || bad;
#pragma unroll
        for (int ai = 0; ai < 2; ++ai)
#pragma unroll
            for (int m = 0; m < 4; ++m) { const int r = ai * HALF + wr * 64 + m * 16 + fr; const f32x2v sr = S[r]; const size_t off = (size_t)(u.pm * BM + r) * ldc + col0;
#pragma unroll
                for (int bj = 0; bj < 2; ++bj)
#pragma unroll
                    for (int n = 0; n < 2; ++n) { const f32x4 x1 = acc[ai][bj][m][n]; *(f32x4*)(out + off + bj * HALF + n * 16) = bad1 ? (f32x4){qnan, qnan, qnan, qnan} : x1;
                        const f32x4 o = (x1 - sr.x) * sr.y; u32x2v w; w.x = cvt_pk_bf16(o[0], o[1]); w.y = cvt_pk_bf16(o[2], o[3]);
                        if (bad) { w.x = 0x7fc07fc0u; w.y = 0x7fc07fc0u; } *(u32x2v*)(xn + off + bj * HALF + n * 16) = w; }
                asm volatile("" ::: "memory"); }
    }
};

template <class Epi, class Sched, bool ALIGN_EPI = false, bool SP2 = false>
__device__ __forceinline__ void gemm_phase(PG8_LAS unsigned char* lds, const Gemm g, const Sched& S, const Epi& E) {
    const int tid = threadIdx.x, wid = __builtin_amdgcn_readfirstlane(tid >> 6), lane = tid & 63, wr = wid >> 2, wc = wid & 3, fr = lane & 15, fq = lane >> 4;
    const int K = g.K, nt = K / BK;
    unsigned voffA[2], voffB[2];
#pragma unroll
    for (int i = 0; i < 2; ++i) { int R, C; stage_rc(tid * 16 + i * 8192, R, C); const int Rb = Epi::PERM ? ((R & ~31) + perm32(R & 31)) : R;
        voffA[i] = (unsigned)(R * K + C) * 2u; voffB[i] = (unsigned)(Rb * K + C) * 2u; }
    const size_t kstep = (size_t)(BK * 2);
    const size_t hstep = (size_t)HALF * K * 2;
    const size_t tstep = 2 * hstep;
    const unsigned ldsw = (unsigned)wid * 1024u;
    const int aoff = lds_byte(wr * 64 + fr, fq * 8), boff = lds_byte(wc * 32 + fr, fq * 8);
#define PG8_SA(b, h) (((b) * 2 + (h)) * HTB)
#define PG8_SB(b, h) ((4 + (b) * 2 + (h)) * HTB)
#define PG8_STAGE(bufoff, gbase, voff) do { _Pragma("unroll") for (int _i = 0; _i < 2; ++_i) \
        __builtin_amdgcn_global_load_lds((const unsigned*)((const char*)(gbase) + (voff)[_i]), (PG8_LAS unsigned*)(lds + (bufoff) + ldsw + _i * 8192), 16, 0, 0); } while (0)
#define PG8_LDA(dst, b, h) do { _Pragma("unroll") for (int m = 0; m < 4; ++m) _Pragma("unroll") for (int k = 0; k < 2; ++k) dst[m][k] = *(const PG8_LAS bf16x8*)(lds + PG8_SA(b, h) + aoff + m * 2048 + k * 1024); } while (0)
#define PG8_LDB(dst, b, h) do { _Pragma("unroll") for (int n = 0; n < 2; ++n) _Pragma("unroll") for (int k = 0; k < 2; ++k) dst[n][k] = *(const PG8_LAS bf16x8*)(lds + PG8_SB(b, h) + boff + n * 2048 + k * 1024); } while (0)
#define PG8_MMA(ai, bj, At, Bt) do { __builtin_amdgcn_s_setprio(1); _Pragma("unroll") for (int m = 0; m < 4; ++m) _Pragma("unroll") for (int n = 0; n < 2; ++n) _Pragma("unroll") for (int k = 0; k < 2; ++k) \
        acc[ai][bj][m][n] = __builtin_amdgcn_mfma_f32_16x16x32_bf16(Bt[n][k], At[m][k], acc[ai][bj][m][n], 0, 0, 0); __builtin_amdgcn_s_setprio(0); } while (0)
#define PG8_WAIT_V(n) asm volatile("s_waitcnt vmcnt(" #n ")" ::: "memory")
#define PG8_WAIT_L(n) asm volatile("s_waitcnt lgkmcnt(" #n ")" ::: "memory")
#define PG8_BAR __builtin_amdgcn_s_barrier()
#define PG8_SCHED __builtin_amdgcn_sched_barrier(0)
    Unit cur, nxt; int ui = 0;
    if (!S.next(0, cur)) return;
    f32x4 acc[2][2][4][2];
#pragma unroll
    for (int a = 0; a < 2; ++a)
#pragma unroll
        for (int b = 0; b < 2; ++b)
#pragma unroll
            for (int m = 0; m < 4; ++m)
#pragma unroll
                for (int n = 0; n < 2; ++n) acc[a][b][m][n] = (f32x4){0.f, 0.f, 0.f, 0.f};
    bf16x8 At[4][2], B0[2][2], B1[2][2];
    const char* cA = (const char*)g.A + (size_t)cur.pm * tstep; const char* cB = (const char*)g.Bt + (size_t)cur.pn * tstep;
    S.a_ready(cur);
    if constexpr (SP2) {
        PG8_STAGE(PG8_SB(0, 0), cB, voffB); PG8_STAGE(PG8_SB(0, 1), cB + hstep, voffB); PG8_STAGE(PG8_SA(0, 0), cA, voffA); PG8_STAGE(PG8_SA(0, 1), cA + hstep, voffA);
        if (wr == 1) PG8_BAR;
        PG8_WAIT_V(2); PG8_BAR;
        PG8_STAGE(PG8_SB(1, 0), cB + kstep, voffB); PG8_STAGE(PG8_SA(1, 0), cA + kstep, voffA); PG8_STAGE(PG8_SB(1, 1), cB + hstep + kstep, voffB);
        PG8_WAIT_V(6); PG8_BAR;
    } else {
        PG8_STAGE(PG8_SB(0, 0), cB, voffB); PG8_STAGE(PG8_SA(0, 0), cA, voffA); PG8_STAGE(PG8_SB(0, 1), cB + hstep, voffB); PG8_STAGE(PG8_SA(0, 1), cA + hstep, voffA);
        if (wr == 1) PG8_BAR;
        PG8_WAIT_V(4); PG8_BAR;
        PG8_STAGE(PG8_SB(1, 0), cB + kstep, voffB); PG8_STAGE(PG8_SA(1, 0), cA + kstep, voffA); PG8_STAGE(PG8_SB(1, 1), cB + hstep + kstep, voffB);
        PG8_WAIT_V(6); PG8_BAR;
    }
    for (;;) {
        const bool has_next = S.next(ui + 1, nxt);
        const char* nA = has_next ? (const char*)g.A + (size_t)nxt.pm * tstep : cA; const char* nB = has_next ? (const char*)g.Bt + (size_t)nxt.pn * tstep : cB;
        for (int t = 0; t < nt; t += 2) {
            const bool last = (t == nt - 2);
            const char* a1 = cA + (size_t)(t + 1) * kstep;
            const char* a2 = last ? nA : cA + (size_t)(t + 2) * kstep; const char* b2 = last ? nB : cB + (size_t)(t + 2) * kstep;
            const char* a3 = a2 + kstep; const char* b3 = b2 + kstep;
            if (last && has_next) S.a_ready(nxt);
            if constexpr (SP2) {
            PG8_LDB(B0, 0, 0); PG8_LDB(B1, 0, 1); PG8_SCHED; PG8_LDA(At, 0, 0); PG8_STAGE(PG8_SA(1, 1), a1 + hstep, voffA);
            PG8_WAIT_V(8); PG8_WAIT_L(0); PG8_BAR; PG8_MMA(0, 0, At, B0); PG8_MMA(0, 1, At, B1); PG8_BAR; PG8_SCHED;
            PG8_LDA(At, 0, 1); PG8_STAGE(PG8_SB(0, 0), b2, voffB); PG8_STAGE(PG8_SB(0, 1), b2 + hstep, voffB); PG8_STAGE(PG8_SA(0, 0), a2, voffA);
            PG8_WAIT_V(8); PG8_WAIT_L(0); PG8_BAR; PG8_MMA(1, 0, At, B0); PG8_MMA(1, 1, At, B1); PG8_BAR; PG8_SCHED;
            PG8_LDB(B0, 1, 0); PG8_LDB(B1, 1, 1); PG8_SCHED; PG8_LDA(At, 1, 0); PG8_STAGE(PG8_SA(0, 1), a2 + hstep, voffA);
            PG8_WAIT_V(8); PG8_WAIT_L(0); PG8_BAR; PG8_MMA(0, 0, At, B0); PG8_MMA(0, 1, At, B1); PG8_BAR; PG8_SCHED;
            PG8_LDA(At, 1, 1); PG8_STAGE(PG8_SB(1, 0), b3, voffB); PG8_STAGE(PG8_SB(1, 1), b3 + hstep, voffB); PG8_STAGE(PG8_SA(1, 0), a3, voffA);
            PG8_WAIT_V(8); PG8_WAIT_L(0); PG8_BAR; PG8_MMA(1, 0, At, B0); PG8_MMA(1, 1, At, B1); PG8_BAR; PG8_SCHED;
            } else {
            PG8_LDB(B0, 0, 0); PG8_SCHED; PG8_LDA(At, 0, 0); PG8_STAGE(PG8_SA(1, 1), a1 + hstep, voffA);
            PG8_WAIT_L(8); PG8_BAR; PG8_WAIT_L(0); PG8_MMA(0, 0, At, B0); PG8_BAR; PG8_SCHED;
            PG8_LDB(B1, 0, 1); PG8_STAGE(PG8_SB(0, 0), b2, voffB);
            PG8_BAR; PG8_WAIT_L(0); PG8_MMA(0, 1, At, B1); PG8_BAR;
            PG8_LDA(At, 0, 1); PG8_STAGE(PG8_SA(0, 0), a2, voffA);
            PG8_BAR; PG8_WAIT_L(0); PG8_MMA(1, 0, At, B0); PG8_BAR; PG8_SCHED;
            PG8_STAGE(PG8_SB(0, 1), b2 + hstep, voffB);
            PG8_WAIT_V(6); PG8_BAR; PG8_MMA(1, 1, At, B1); PG8_BAR;
            PG8_LDB(B0, 1, 0); PG8_SCHED; PG8_LDA(At, 1, 0); PG8_STAGE(PG8_SA(0, 1), a2 + hstep, voffA);
            PG8_WAIT_L(8); PG8_BAR; PG8_WAIT_L(0); PG8_MMA(0, 0, At, B0); PG8_BAR; PG8_SCHED;
            PG8_LDB(B1, 1, 1); PG8_STAGE(PG8_SB(1, 0), b3, voffB);
            PG8_BAR; PG8_WAIT_L(0); PG8_MMA(0, 1, At, B1); PG8_BAR;
            PG8_LDA(At, 1, 1); PG8_STAGE(PG8_SA(1, 0), a3, voffA);
            PG8_BAR; PG8_WAIT_L(0); PG8_MMA(1, 0, At, B0); PG8_BAR; PG8_SCHED;
            PG8_STAGE(PG8_SB(1, 1), b3 + hstep, voffB);
            PG8_WAIT_V(6); PG8_BAR; PG8_MMA(1, 1, At, B1); PG8_BAR;
            }
        }
        if constexpr (ALIGN_EPI) { if (wr == 0) PG8_BAR; }
        if constexpr (!Epi::AFTER_DRAIN) { E(acc, cur, wr, wc, fr, fq); S.done(cur); }
        if (!has_next) break;
#pragma unroll
        for (int a = 0; a < 2; ++a)
#pragma unroll
            for (int b = 0; b < 2; ++b)
#pragma unroll
                for (int m = 0; m < 4; ++m)
#pragma unroll
                    for (int n = 0; n < 2; ++n) acc[a][b][m][n] = (f32x4){0.f, 0.f, 0.f, 0.f};
        cur = nxt; cA = nA; cB = nB; ++ui;
        if constexpr (ALIGN_EPI) { if (wr == 1) PG8_BAR; }
    }
    PG8_WAIT_V(0);
    if constexpr (!ALIGN_EPI) { if (wr == 0) PG8_BAR; }
    PG8_BAR;
    if constexpr (Epi::AFTER_DRAIN) { E.fused(acc, cur, wr, wc, fr, fq, lds, wid, lane); S.done(cur); }
#undef PG8_SA
#undef PG8_SB
#undef PG8_STAGE
#undef PG8_LDA
#undef PG8_LDB
#undef PG8_MMA
#undef PG8_WAIT_V
#undef PG8_WAIT_L
#undef PG8_BAR
#undef PG8_SCHED
}
}
#define LAS __attribute__((address_space(3)))
#define GAS __attribute__((address_space(1)))
#define XB_TMO      128
#define XB_XCNT(j)  (256  + 64 * (j))
#define XB_XSUB(j)  (1280 + 64 * (j))
#define XB_XGEN(j)  (2304 + 64 * (j))
#define XB_TOP      3328
#define XB_TOPGEN   3392
#define XCD_BAR_WORDS 3456
#define XB_SPIN_CAP (1u << 18)
typedef unsigned short bf16;
typedef unsigned v4u __attribute__((ext_vector_type(4)));
typedef unsigned v2u __attribute__((ext_vector_type(2)));
typedef float f32x4 __attribute__((ext_vector_type(4)));
typedef float f32x16 __attribute__((ext_vector_type(16)));
typedef short bf16x8 __attribute__((ext_vector_type(8)));

constexpr int NWAVES = 8, NTHR = 512;
constexpr int D = 1024, BATCH = 8, SEQ = 2048, M = BATCH * SEQ;
constexpr int CONVW = 512, GK = 256, NH = 4, DK = 64, DV = 128, RANK = 16;
constexpr int INC = 3088, NPROJ = 3072;
constexpr int PH = 8, NKEYS = 128, TOPK = 16, NQ = 2048;
constexpr float LN_EPS = 1e-5f, RMS_EPS = 1e-6f;
constexpr float ALPHA = 1.189207115002721f;
constexpr size_t MiB = 1u << 20;
constexpr size_t WS_CTL = 0, CTL_ZERO_BYTES = 1 * MiB;
constexpr size_t WS_MOD = 1 * MiB;
constexpr size_t WS_WIN = 2 * MiB;
constexpr size_t WS_WGLR = 8 * MiB;
constexpr size_t WS_WOUT = 9 * MiB;
constexpr size_t WS_WQ = 11 * MiB;
constexpr size_t WS_SUBK = 15 * MiB;
constexpr size_t WS_PU = 16 * MiB, WS_PV = 48 * MiB;
constexpr size_t WS_H = 80 * MiB;
constexpr size_t WS_PROJ = 112 * MiB;
constexpr size_t WS_X1 = 112 * MiB;
constexpr size_t WS_H2 = 176 * MiB;
constexpr size_t WS_GLR = 208 * MiB;
constexpr size_t WS_IDX = 209 * MiB, WS_GATE = 217 * MiB;
constexpr int CW_BAR = 4096;

constexpr int RING_BYTES = 131072, LDSCTL_OFF = RING_BYTES, MISC_OFF = LDSCTL_OFF + 320, LDS_BYTES = 147456;

__device__ __forceinline__ unsigned f2bf(float f) { unsigned u = __builtin_bit_cast(unsigned, f); return (u + 0x7fffu + ((u >> 16) & 1u)) >> 16; }
__device__ __forceinline__ unsigned pk2(float lo, float hi) { return f2bf(lo) | (f2bf(hi) << 16); }
__device__ __forceinline__ float bflo(unsigned w) { return __builtin_bit_cast(float, w << 16); }
__device__ __forceinline__ float bfhi(unsigned w) { return __builtin_bit_cast(float, w & 0xffff0000u); }
__device__ __forceinline__ float bf2f(bf16 v) { return __builtin_bit_cast(float, (unsigned)v << 16); }
__device__ __forceinline__ float silu_f(float v) { return v / (1.f + __expf(-v)); }
__device__ __forceinline__ float gelu_f(float v) { return 0.5f * v * (1.f + erff(v * 0.70710678118654752f)); }
__device__ __forceinline__ float logsig_f(float z) { return fminf(z, 0.f) - log1pf(__expf(-fabsf(z))); }
__device__ __forceinline__ float wave_sum(float v) {
#pragma unroll
    for (int o = 1; o < 64; o <<= 1) v += __shfl_xor(v, o);
    return v;
}
#define LDS_WAIT() asm volatile("s_waitcnt lgkmcnt(0)" ::: "memory")


__device__ __forceinline__ unsigned xb_ld(unsigned* p)              { return __hip_atomic_load(p, __ATOMIC_RELAXED, __HIP_MEMORY_SCOPE_AGENT); }
__device__ __forceinline__ unsigned xb_add(unsigned* p, unsigned v) { return __hip_atomic_fetch_add(p, v, __ATOMIC_RELAXED, __HIP_MEMORY_SCOPE_AGENT); }
__device__ __forceinline__ unsigned xb_xcc_id() { return (unsigned)__builtin_amdgcn_s_getreg((3 << 11) | 20) & 0xFu; }
#define XB_SPIN(cond, bar) do { unsigned _sp = 0; while (cond) { __builtin_amdgcn_s_sleep(1); \
    if ((++_sp & 255u) == 0u) { if (xb_ld(&(bar)[XB_TMO])) break; if (_sp > XB_SPIN_CAP) { atomicAdd(&(bar)[XB_TMO], 1u); break; } } } } while (0)

struct XcdBarrier {
    unsigned* bar; unsigned x;
    volatile LAS unsigned* st;
};

__device__ __forceinline__ XcdBarrier xcd_barrier_post(unsigned* bar, volatile LAS unsigned* st) {
    XcdBarrier b; b.bar = bar; b.x = xb_xcc_id(); b.st = st;
    if (threadIdx.x == 0) (void)xb_add(&bar[XB_XCNT(b.x)], 1u);
    return b;
}
__device__ __forceinline__ void xcd_barrier_complete(unsigned* bar, unsigned x, unsigned& nloc, unsigned& nx) {
    const unsigned G = gridDim.x * gridDim.y * gridDim.z;
    unsigned sum, cnt, mine, sp = 0u;
    for (;;) {
        sum = 0u; cnt = 0u; mine = 0u;
#pragma unroll
        for (unsigned j = 0; j < 16; ++j) { const unsigned c = xb_ld(&bar[XB_XCNT(j)]); sum += c; cnt += (c > 0u) ? 1u : 0u; mine = (j == x) ? c : mine; }
        if (sum == G) break;
        __builtin_amdgcn_s_sleep(1);
        if ((++sp & 255u) == 0u) { if (xb_ld(&bar[XB_TMO])) break; if (sp > XB_SPIN_CAP) { atomicAdd(&bar[XB_TMO], 1u); break; } }
    }
    nloc = mine > 0u ? mine : 1u; nx = cnt > 0u ? cnt : 1u;
}

__device__ __forceinline__ void xcd_barrier(const XcdBarrier& b) {
    asm volatile("s_waitcnt vmcnt(0)" ::: "memory");
    __syncthreads();
    if (threadIdx.x == 0) {
        unsigned* bar = b.bar;
        __builtin_amdgcn_s_waitcnt(0);
        unsigned nloc = b.st[0], nx = b.st[1];
        if (nloc == 0u) { xcd_barrier_complete(bar, b.x, nloc, nx); b.st[0] = nloc; b.st[1] = nx; }
        const unsigned old = xb_add(&bar[XB_XSUB(b.x)], 1u);
        const unsigned gen = old / nloc;
        if (old + 1u == (gen + 1u) * nloc) {
            __builtin_amdgcn_fence(__ATOMIC_RELEASE, "agent");
            asm volatile("s_waitcnt vmcnt(0)" ::: "memory");
            const unsigned og = xb_add(&bar[XB_TOP], 1u);
            const unsigned tg = og / nx;
            if (og + 1u == (tg + 1u) * nx) xb_add(&bar[XB_TOPGEN], 1u);
            else XB_SPIN(xb_ld(&bar[XB_TOPGEN]) == tg, bar);
            __builtin_amdgcn_fence(__ATOMIC_ACQUIRE, "agent");
            xb_add(&bar[XB_XGEN(b.x)], 1u);
            asm volatile("s_waitcnt vmcnt(0)" ::: "memory");
        } else {
            XB_SPIN(xb_ld(&bar[XB_XGEN(b.x)]) == gen, bar);
            __builtin_amdgcn_fence(__ATOMIC_ACQUIRE, "agent");
            asm volatile("s_waitcnt vmcnt(0)" ::: "memory");
        }
    }
    __syncthreads();
}


constexpr int ARGT_OFF = LDSCTL_OFF + 1024;
enum ArgIdx { A_X = 0, A_C, A_WMOD, A_BMOD, A_WIN, A_CONVW, A_GATEUP, A_GATEBIAS, A_NORMG, A_WOUT, A_LN1G, A_LN1B, A_WQ, A_SUBK, A_PU, A_PV, A_LN2G, A_LN2B, A_OUT, A_WS, A_COUNT };
struct Ctx { LAS unsigned char* lds; int tid, lane, wave, wg, G, gw, NGW; };
__device__ __forceinline__ unsigned long long ldarg(const Ctx& C, int i) {
    volatile LAS unsigned* p = (volatile LAS unsigned*)(C.lds + ARGT_OFF) + 2 * i;
    const unsigned lo = __builtin_amdgcn_readfirstlane(p[0]), hi = __builtin_amdgcn_readfirstlane(p[1]);
    return ((unsigned long long)hi << 32) | lo;
}
#define ARGF(i) ((const float*)ldarg(C, (i)))
#define ARG_WS ((unsigned char*)ldarg(C, A_WS))
#define ARG_OUT ((float*)ldarg(C, A_OUT))

__device__ __forceinline__ void p0_mod_item(const Ctx& C, int item) {
    LAS float* sc = (LAS float*)C.lds; LAS float* red = sc + BATCH * D;
    float* mod = (float*)(ARG_WS + WS_MOD); const float* c_in = ARGF(A_C); const float* w_mod = ARGF(A_WMOD); const float* b_mod = ARGF(A_BMOD);
    for (int i = C.tid; i < BATCH * D; i += NTHR) sc[i] = silu_f(c_in[i]);
    __syncthreads();
    const int col = C.lane & 31, kp = C.lane >> 5, n0 = item * 32;
    float acc[BATCH];
#pragma unroll
    for (int b = 0; b < BATCH; ++b) acc[b] = 0.f;
    for (int i = 0; i < 64; ++i) {
        const int k = 128 * C.wave + 2 * i + kp; const float wv = w_mod[(size_t)k * (6 * D) + n0 + col];
#pragma unroll
        for (int b = 0; b < BATCH; ++b) acc[b] += sc[b * D + k] * wv;
    }
#pragma unroll
    for (int b = 0; b < BATCH; ++b) acc[b] += __shfl_xor(acc[b], 32);
    if (C.lane < 32) {
#pragma unroll
        for (int b = 0; b < BATCH; ++b) red[(C.wave * 8 + b) * 32 + col] = acc[b];
    }
    __syncthreads();
    if (C.tid < 256) { const int b = C.tid >> 5, cc = C.tid & 31; float s = b_mod[n0 + cc];
#pragma unroll
        for (int w = 0; w < 8; ++w) s += red[(w * 8 + b) * 32 + cc];
        mod[b * (6 * D) + n0 + cc] = s; }
    __syncthreads();
}
__device__ __forceinline__ void p0_transpose_item(const float* W, int ldw, int K, int k0, int n0, bf16* WT, LAS float* scr, int lane) {
#pragma unroll 8
    for (int i = 0; i < 32; ++i) { const int kk = 2 * i + (lane >> 5); scr[kk * 33 + (lane & 31)] = W[(size_t)(k0 + kk) * ldw + n0 + (lane & 31)]; }
    LDS_WAIT(); asm volatile("" ::: "memory");
    const int c = lane & 7;
#pragma unroll
    for (int j = 0; j < 4; ++j) { const int n = (lane >> 3) + 8 * j; const LAS float* s = scr + (8 * c) * 33 + n;
        v4u o; o.x = pk2(s[0 * 33], s[1 * 33]); o.y = pk2(s[2 * 33], s[3 * 33]); o.z = pk2(s[4 * 33], s[5 * 33]); o.w = pk2(s[6 * 33], s[7 * 33]);
        *(v4u*)(WT + (size_t)(n0 + n) * K + k0 + 8 * c) = o; }
    LDS_WAIT(); asm volatile("" ::: "memory");
}
__device__ __forceinline__ void p0_cvt_item(const float* src, bf16* dst, size_t item, int lane) {
#pragma unroll
    for (int r = 0; r < 4; ++r) { const size_t off = item * 2048 + r * 512 + lane * 8; const f32x4 a = *(const f32x4*)(src + off), b = *(const f32x4*)(src + off + 4);
        v4u o; o.x = pk2(a.x, a.y); o.y = pk2(a.z, a.w); o.z = pk2(b.x, b.y); o.w = pk2(b.z, b.w); *(v4u*)(dst + off) = o; }
}
typedef float f32x2 __attribute__((ext_vector_type(2)));
constexpr float PU_SCALE = 32.f, PV_SCALE = 2.f;
__device__ __forceinline__ void p0_cvt8_item(const float* src, unsigned char* dst, size_t item, int lane, float scale) {
#pragma unroll
    for (int r = 0; r < 4; ++r) { const size_t off = item * 4096 + r * 1024 + lane * 16; v4u o;
#pragma unroll
        for (int q = 0; q < 4; ++q) { const f32x4 a = *(const f32x4*)(src + off + 4 * q) * scale; int pk = __builtin_amdgcn_cvt_pk_fp8_f32(a.x, a.y, 0, false); pk = __builtin_amdgcn_cvt_pk_fp8_f32(a.z, a.w, pk, true); o[q] = (unsigned)pk; }
        *(v4u*)(dst + off) = o; }
}
__device__ __forceinline__ void phase0(const Ctx& C) {
    if (C.wg < 192) p0_mod_item(C, C.wg);
    LAS float* scr = (LAS float*)(C.lds + C.wave * 16384);
    unsigned char* ws = ARG_WS; const float* w_in = ARGF(A_WIN); const float* w_out = ARGF(A_WOUT); const float* wq = ARGF(A_WQ); const float* pu = ARGF(A_PU); const float* pv = ARGF(A_PV); const float* subkeys = ARGF(A_SUBK);
    bf16* WIN = (bf16*)(ws + WS_WIN); bf16* WOUT = (bf16*)(ws + WS_WOUT); bf16* WQ = (bf16*)(ws + WS_WQ); bf16* WGLR = (bf16*)(ws + WS_WGLR);
    unsigned char* PU = ws + WS_PU; unsigned char* PV = ws + WS_PV; bf16* SUBK = (bf16*)(ws + WS_SUBK);
    constexpr int I_IN = 16 * 96, I_OUT = 16 * 32, I_Q = 16 * 64, I_U = 4096, I_S = 128;
    constexpr int NITEMS = I_IN + I_OUT + I_Q + 2 * I_U + I_S;
    for (int it = C.gw; it < NITEMS; it += C.NGW) {
        int r = it;
        if (r < I_IN) { p0_transpose_item(w_in, INC, D, 64 * (r / 96), 32 * (r % 96), WIN, scr, C.lane); continue; } r -= I_IN;
        if (r < I_OUT) { p0_transpose_item(w_out, D, D, 64 * (r / 32), 32 * (r % 32), WOUT, scr, C.lane); continue; } r -= I_OUT;
        if (r < I_Q) { p0_transpose_item(wq, NQ, D, 64 * (r / 64), 32 * (r % 64), WQ, scr, C.lane); continue; } r -= I_Q;
        if (r < I_U) { p0_cvt8_item(pu, PU, (size_t)r, C.lane, PU_SCALE); continue; } r -= I_U;
        if (r < I_U) { p0_cvt8_item(pv, PV, (size_t)r, C.lane, PV_SCALE); continue; } r -= I_U;
        p0_cvt_item(subkeys, SUBK, (size_t)r, C.lane);
    }
    for (int i = C.gw * 64 + C.lane; i < RANK * D; i += C.NGW * 64) { const int j = i >> 10, k = i & 1023; WGLR[i] = (bf16)f2bf(w_in[(size_t)k * INC + NPROJ + j]); }
}
__device__ __forceinline__ void phase0b(const Ctx& C) {
    unsigned char* ws = ARG_WS; const float* x = ARGF(A_X);
    const float* mod = (const float*)(ws + WS_MOD); bf16* H = (bf16*)(ws + WS_H);
    for (int m = C.gw; m < M; m += C.NGW) {
        const int b = m / SEQ; const f32x4* sh = (const f32x4*)(mod + b * 6 * D) + C.lane; const f32x4* sc = (const f32x4*)(mod + b * 6 * D + D) + C.lane;
        const f32x4* xr = (const f32x4*)(x + (size_t)m * D) + C.lane;
        unsigned long long* o8 = (unsigned long long*)(H + (size_t)m * D) + C.lane;
#pragma unroll
        for (int j = 0; j < 4; ++j) { const f32x4 v = xr[64 * j] * (sc[64 * j] + 1.0f) + sh[64 * j]; o8[64 * j] = (unsigned long long)pk2(v.x, v.y) | ((unsigned long long)pk2(v.z, v.w) << 32); }
    }
}
struct EpiF32 {
    static constexpr bool PERM = false, AFTER_DRAIN = false;
    float* O; int ldc;
    __device__ __forceinline__ void operator()(const pg8::f32x4 (&acc)[2][2][4][2], const pg8::Unit& u, int wr, int wc, int fr, int fq) const {
        const int col0 = u.pn * 256 + wc * 32 + 4 * fq;
#pragma unroll
        for (int ai = 0; ai < 2; ++ai)
#pragma unroll
            for (int m = 0; m < 4; ++m) { float* rowp = O + (size_t)(u.pm * 256 + ai * 128 + wr * 64 + m * 16 + fr) * ldc + col0;
#pragma unroll
                for (int bj = 0; bj < 2; ++bj)
#pragma unroll
                    for (int n = 0; n < 2; ++n) *(pg8::f32x4*)(rowp + bj * 128 + n * 16) = acc[ai][bj][m][n]; }
    }
};
__device__ __forceinline__ void glr_simple(const Ctx& C) {
    unsigned char* ws = ARG_WS;
    const bf16* H = (const bf16*)(ws + WS_H); const bf16* WGLR = (const bf16*)(ws + WS_WGLR); float* GLR = (float*)(ws + WS_GLR);
    for (int i = C.gw * 64 + C.lane; i < M * RANK; i += C.NGW * 64) {
        const int m = i >> 4, j = i & 15; const v4u* hr = (const v4u*)(H + (size_t)m * D); const v4u* wr = (const v4u*)(WGLR + (size_t)j * D);
        float acc = 0.f;
        for (int kc = 0; kc < 128; ++kc) { const v4u a = hr[kc], w = wr[kc];
            acc += bflo(a.x) * bflo(w.x) + bfhi(a.x) * bfhi(w.x) + bflo(a.y) * bflo(w.y) + bfhi(a.y) * bfhi(w.y) + bflo(a.z) * bflo(w.z) + bfhi(a.z) * bfhi(w.z) + bflo(a.w) * bflo(w.w) + bfhi(a.w) * bfhi(w.w); }
        GLR[i] = acc;
    }
}
__device__ __forceinline__ void conv_phase(const Ctx& C) {
    unsigned char* ws = ARG_WS; const float* conv_w = ARGF(A_CONVW);
    const bf16* PROJ = (const bf16*)(ws + WS_PROJ); bf16* YMIX = (bf16*)(ws + WS_H);
    for (int i = C.gw * 64 + C.lane; i < M * 64; i += C.NGW * 64) {
        const int m = i >> 6, c = (i & 63) * 8, s = m % SEQ;
        float z[8];
#pragma unroll
        for (int k = 0; k < 8; ++k) z[k] = 0.f;
#pragma unroll
        for (int j = 0; j < 3; ++j) { const int sp = s - 2 + j;
            if (sp >= 0) { const bf16* row = PROJ + (size_t)(m - 2 + j) * NPROJ; const v4u cc = *(const v4u*)(row + CONVW + c), ch = *(const v4u*)(row + 2 * CONVW + c);
                const f32x4 w0 = *(const f32x4*)(conv_w + j * CONVW + c), w1 = *(const f32x4*)(conv_w + j * CONVW + c + 4);
                z[0] += w0.x * bflo(cc.x) * bflo(ch.x); z[1] += w0.y * bfhi(cc.x) * bfhi(ch.x); z[2] += w0.z * bflo(cc.y) * bflo(ch.y); z[3] += w0.w * bfhi(cc.y) * bfhi(ch.y);
                z[4] += w1.x * bflo(cc.z) * bflo(ch.z); z[5] += w1.y * bfhi(cc.z) * bfhi(ch.z); z[6] += w1.z * bflo(cc.w) * bflo(ch.w); z[7] += w1.w * bfhi(cc.w) * bfhi(ch.w); } }
        const v4u cb = *(const v4u*)(PROJ + (size_t)m * NPROJ + c);
        v4u o; o.x = pk2(bflo(cb.x) * z[0], bfhi(cb.x) * z[1]); o.y = pk2(bflo(cb.y) * z[2], bfhi(cb.y) * z[3]); o.z = pk2(bflo(cb.z) * z[4], bfhi(cb.z) * z[5]); o.w = pk2(bflo(cb.w) * z[6], bfhi(cb.w) * z[7]);
        *(v4u*)(YMIX + (size_t)m * D + c) = o;
    }
}
constexpr size_t GO_KV = 0, GO_SPREV = 34 * MiB, GO_DECAY = 52 * MiB;
constexpr int G_GLR = 0, G_T = 4096, G_K = 8192, G_Q = 16384, G_V = 24576, G_S = 43008, G_QE = 61440, G_KE = 70656, G_AT = 79872, G_SS = 90112;
constexpr int VS_B = 272, QS_B = 144;
typedef short v4i16_t __attribute__((ext_vector_type(4)));
__device__ __forceinline__ bf16x8 tr_frag(const LAS unsigned char* tile, int stride, int ks, int c, int lane) {
    const int g = lane >> 4, q = (lane & 15) >> 2, pp = lane & 3;
    const LAS unsigned char* a = tile + (32 * ks + 8 * g + q) * stride + (16 * c + 4 * pp) * 2;
    const v4i16_t lo = __builtin_amdgcn_ds_read_tr16_b64_v4i16((LAS v4i16_t*)a);
    const v4i16_t hi = __builtin_amdgcn_ds_read_tr16_b64_v4i16((LAS v4i16_t*)(a + 4 * stride));
    bf16x8 r; r[0] = lo[0]; r[1] = lo[1]; r[2] = lo[2]; r[3] = lo[3]; r[4] = hi[0]; r[5] = hi[1]; r[6] = hi[2]; r[7] = hi[3]; return r;
}
__device__ __forceinline__ bf16x8 row_frag(const LAS unsigned char* tile, int stride, int ks, int c, int lane) {
    return *(const LAS bf16x8*)(tile + (16 * c + (lane & 15)) * stride + (32 * ks + 8 * (lane >> 4)) * 2);
}
template <bool PASS_C>
__device__ __forceinline__ void gla_stage_prefix(const Ctx& C, const bf16* PROJ, const float* GLR, const bf16* SPREV, const float* gate_up, const float* gate_bias, int m0, int hd, int kvidx, float (&bc)[8], float& blast) {
    const int tid = C.tid;
    __syncthreads();
    if (tid < 256) *(LAS v4u*)(C.lds + G_GLR + tid * 16) = *(const v4u*)(GLR + (size_t)m0 * RANK + tid * 4);
    { const int row = tid >> 3, ch = tid & 7; const bf16* src = PROJ + (size_t)(m0 + row) * NPROJ + hd * DK + ch * 8;
      *(LAS v4u*)(C.lds + G_K + row * 128 + ch * 16) = *(const v4u*)(src + 1792);
      if (PASS_C) *(LAS v4u*)(C.lds + G_Q + row * 128 + ch * 16) = *(const v4u*)(src + 1536); }
#pragma unroll
    for (int i = 0; i < 2; ++i) { const int idx = tid + i * NTHR, row = idx >> 4, ch = idx & 15;
        *(LAS v4u*)(C.lds + G_V + row * VS_B + ch * 16) = *(const v4u*)(PROJ + (size_t)(m0 + row) * NPROJ + 2048 + hd * DV + ch * 8);
        if (PASS_C) *(LAS v4u*)(C.lds + G_S + row * VS_B + ch * 16) = *(const v4u*)(SPREV + (size_t)kvidx * (DK * DV) + row * DV + ch * 8); }
    const int d = tid & 63, rb = tid >> 6;
    float gu[RANK];
#pragma unroll
    for (int j = 0; j < RANK; ++j) gu[j] = gate_up[j * GK + hd * DK + d];
    const float bias = gate_bias[hd * DK + d];
    __syncthreads();
    float run = 0.f;
#pragma unroll
    for (int i = 0; i < 8; ++i) { const LAS float* gr = (const LAS float*)(C.lds + G_GLR) + (rb * 8 + i) * RANK; float z = bias;
#pragma unroll
        for (int j = 0; j < RANK; ++j) z += gr[j] * gu[j];
        run += logsig_f(z) * (1.f / 16.f); bc[i] = run; }
    ((LAS float*)(C.lds + G_T))[rb * 64 + d] = run;
    __syncthreads();
    float off = 0.f; blast = 0.f;
#pragma unroll
    for (int r2 = 0; r2 < 8; ++r2) { const float tv = ((const LAS float*)(C.lds + G_T))[r2 * 64 + d]; blast += tv; if (r2 < rb) off += tv; }
#pragma unroll
    for (int i = 0; i < 8; ++i) bc[i] += off;
}
__device__ __forceinline__ void gla_pass_a(const Ctx& C) {
    unsigned char* ws = ARG_WS; unsigned char* ob = (unsigned char*)ARG_OUT; const float* gate_up = ARGF(A_GATEUP); const float* gate_bias = ARGF(A_GATEBIAS);
    const bf16* PROJ = (const bf16*)(ws + WS_PROJ); const float* GLR = (const float*)(ws + WS_GLR);
    float* KV = (float*)(ob + GO_KV); float* DECAY = (float*)(ob + GO_DECAY);
    const int lane = C.lane, w = C.wave;
    for (int item = C.wg; item < BATCH * 32 * NH; item += C.G) {
        const int hd = item & 3, bn = item >> 2, b = bn >> 5, n = bn & 31, m0 = bn * 64, kvidx = (b * NH + hd) * 32 + n;
        float bc[8], blast;
        gla_stage_prefix<false>(C, PROJ, GLR, nullptr, gate_up, gate_bias, m0, hd, kvidx, bc, blast);
        const int d = C.tid & 63, rb = C.tid >> 6;
#pragma unroll
        for (int i = 0; i < 8; ++i) { const int r = rb * 8 + i; const float kk = bf2f(*(const LAS bf16*)(C.lds + G_K + r * 128 + d * 2));
            *(LAS bf16*)(C.lds + G_QE + r * QS_B + d * 2) = (bf16)f2bf(kk * __expf(blast - bc[i])); }
        if (rb == 0) DECAY[(size_t)kvidx * DK + d] = __expf(blast);
        __syncthreads();
        const int dt = w & 3, e0 = (w >> 2) * 4;
        f32x4 acc[4];
#pragma unroll
        for (int j = 0; j < 4; ++j) acc[j] = (f32x4){0.f, 0.f, 0.f, 0.f};
#pragma unroll
        for (int ks = 0; ks < 2; ++ks) { const bf16x8 a = tr_frag(C.lds + G_QE, QS_B, ks, dt, lane);
#pragma unroll
            for (int j = 0; j < 4; ++j) { const bf16x8 bb = tr_frag(C.lds + G_V, VS_B, ks, e0 + j, lane); acc[j] = __builtin_amdgcn_mfma_f32_16x16x32_bf16(a, bb, acc[j], 0, 0, 0); } }
        float* kvp = KV + (size_t)kvidx * (DK * DV);
#pragma unroll
        for (int j = 0; j < 4; ++j)
#pragma unroll
            for (int r = 0; r < 4; ++r) kvp[(16 * dt + 4 * (lane >> 4) + r) * DV + 16 * (e0 + j) + (lane & 15)] = acc[j][r];
    }
    __syncthreads();
}
__device__ __forceinline__ void gla_scan(const Ctx& C) {
    unsigned char* ob = (unsigned char*)ARG_OUT;
    const float* KV = (const float*)(ob + GO_KV); const float* DECAY = (const float*)(ob + GO_DECAY); unsigned* SP = (unsigned*)(ob + GO_SPREV);
    for (int gt = C.gw * 64 + C.lane; gt < BATCH * NH * DK * (DV / 2); gt += C.NGW * 64) {
        const int bh = gt >> 12, d = (gt >> 6) & 63, e2 = gt & 63;
        float s0 = 0.f, s1 = 0.f;
#pragma unroll 8
        for (int n = 0; n < 32; ++n) { const size_t base = (size_t)(bh * 32 + n) * (DK * DV) + d * DV + 2 * e2;
            const float2 kv = *(const float2*)(KV + base); const float dec = DECAY[(size_t)(bh * 32 + n) * DK + d];
            SP[base >> 1] = pk2(s0, s1); s0 = dec * s0 + kv.x; s1 = dec * s1 + kv.y; }
    }
}
__device__ __forceinline__ void gla_pass_c(const Ctx& C) {
    unsigned char* ws = ARG_WS; unsigned char* ob = (unsigned char*)ARG_OUT; const float* gate_up = ARGF(A_GATEUP); const float* gate_bias = ARGF(A_GATEBIAS); const float* norm_g = ARGF(A_NORMG);
    const bf16* PROJ = (const bf16*)(ws + WS_PROJ); const float* GLR = (const float*)(ws + WS_GLR); bf16* YMIX = (bf16*)(ws + WS_H);
    const bf16* SPREV = (const bf16*)(ob + GO_SPREV);
    const int lane = C.lane, w = C.wave, fr = lane & 15, fq = lane >> 4;
    for (int item = C.wg; item < BATCH * 32 * NH; item += C.G) {
        const int hd = item & 3, bn = item >> 2, b = bn >> 5, n = bn & 31, m0 = bn * 64, kvidx = (b * NH + hd) * 32 + n;
        float bc[8], blast;
        gla_stage_prefix<true>(C, PROJ, GLR, SPREV, gate_up, gate_bias, m0, hd, kvidx, bc, blast);
        const int d = C.tid & 63, rb = C.tid >> 6;
#pragma unroll
        for (int i = 0; i < 8; ++i) { const int r = rb * 8 + i; const float kk = bf2f(*(const LAS bf16*)(C.lds + G_K + r * 128 + d * 2)), qq = bf2f(*(const LAS bf16*)(C.lds + G_Q + r * 128 + d * 2));
            *(LAS bf16*)(C.lds + G_QE + r * QS_B + d * 2) = (bf16)f2bf(qq * 0.125f * __expf(bc[i]));
            *(LAS bf16*)(C.lds + G_KE + r * QS_B + d * 2) = (bf16)f2bf(kk * __expf(-bc[i])); }
        __syncthreads();
        {
            const int ct = w >> 1, mt0 = (w & 1) * 2;
            f32x4 at[2] = {(f32x4){0.f, 0.f, 0.f, 0.f}, (f32x4){0.f, 0.f, 0.f, 0.f}};
#pragma unroll
            for (int ks = 0; ks < 2; ++ks) { const bf16x8 a = row_frag(C.lds + G_QE, QS_B, ks, ct, lane);
#pragma unroll
                for (int j = 0; j < 2; ++j) { const bf16x8 bb = row_frag(C.lds + G_KE, QS_B, ks, mt0 + j, lane); at[j] = __builtin_amdgcn_mfma_f32_16x16x32_bf16(a, bb, at[j], 0, 0, 0); } }
#pragma unroll
            for (int j = 0; j < 2; ++j)
#pragma unroll
                for (int r = 0; r < 4; ++r) { const int cc = 16 * ct + 4 * fq + r, mm = 16 * (mt0 + j) + fr; *(LAS bf16*)(C.lds + G_AT + cc * QS_B + mm * 2) = (bf16)f2bf(mm <= cc ? at[j][r] : 0.f); }
        }
        __syncthreads();
        const int ct = w & 3, e0 = (w >> 2) * 4;
        f32x4 acc[4];
#pragma unroll
        for (int j = 0; j < 4; ++j) acc[j] = (f32x4){0.f, 0.f, 0.f, 0.f};
#pragma unroll
        for (int ks = 0; ks < 2; ++ks) { const bf16x8 a = row_frag(C.lds + G_AT, QS_B, ks, ct, lane);
#pragma unroll
            for (int j = 0; j < 4; ++j) { const bf16x8 bb = tr_frag(C.lds + G_V, VS_B, ks, e0 + j, lane); acc[j] = __builtin_amdgcn_mfma_f32_16x16x32_bf16(a, bb, acc[j], 0, 0, 0); } }
#pragma unroll
        for (int ks = 0; ks < 2; ++ks) { const bf16x8 a = row_frag(C.lds + G_QE, QS_B, ks, ct, lane);
#pragma unroll
            for (int j = 0; j < 4; ++j) { const bf16x8 bb = tr_frag(C.lds + G_S, VS_B, ks, e0 + j, lane); acc[j] = __builtin_amdgcn_mfma_f32_16x16x32_bf16(a, bb, acc[j], 0, 0, 0); } }
        float ss[4];
#pragma unroll
        for (int r = 0; r < 4; ++r) { float s = 0.f;
#pragma unroll
            for (int j = 0; j < 4; ++j) s += acc[j][r] * acc[j][r];
            s += __shfl_xor(s, 1); s += __shfl_xor(s, 2); s += __shfl_xor(s, 4); s += __shfl_xor(s, 8); ss[r] = s; }
        if (fr == 0) {
#pragma unroll
            for (int r = 0; r < 4; ++r) ((LAS float*)(C.lds + G_SS))[(16 * ct + 4 * fq + r) * 2 + (w >> 2)] = ss[r]; }
        __syncthreads();
#pragma unroll
        for (int r = 0; r < 4; ++r) { const int cc = 16 * ct + 4 * fq + r; const LAS float* sp = (const LAS float*)(C.lds + G_SS) + cc * 2;
            const float rs = rsqrtf((sp[0] + sp[1]) * (1.f / DV) + RMS_EPS); const size_t m = (size_t)(m0 + cc);
#pragma unroll
            for (int j = 0; j < 4; ++j) { const int e = 16 * (e0 + j) + fr; const float rr = bf2f(PROJ[m * NPROJ + 2560 + hd * DV + e]);
                YMIX[m * D + CONVW + hd * DV + e] = (bf16)f2bf(acc[j][r] * rs * norm_g[hd * DV + e] * silu_f(rr)); } }
    }
    __syncthreads();
}
__device__ __forceinline__ void ln1_phase(const Ctx& C) {
    unsigned char* ws = ARG_WS; const float* x = ARGF(A_X); const float* ln1_g = ARGF(A_LN1G); const float* ln1_b = ARGF(A_LN1B);
    const float* mod = (const float*)(ws + WS_MOD); const float* Y = ARG_OUT; float* X1 = (float*)(ws + WS_X1); bf16* H2 = (bf16*)(ws + WS_H2);
    for (int m = C.gw; m < M; m += C.NGW) {
        const int b = m / SEQ; const float* mrow = mod + b * 6 * D;
        const f32x4* g1 = (const f32x4*)(mrow + 2 * D) + C.lane; const f32x4* sh2 = (const f32x4*)(mrow + 3 * D) + C.lane; const f32x4* sc2 = (const f32x4*)(mrow + 4 * D) + C.lane;
        const f32x4* xr = (const f32x4*)(x + (size_t)m * D) + C.lane; const f32x4* yr = (const f32x4*)(Y + (size_t)m * D) + C.lane;
        f32x4 v[4]; float s = 0.f;
#pragma unroll
        for (int j = 0; j < 4; ++j) { v[j] = xr[64 * j] * ALPHA + (g1[64 * j] + 1.0f) * yr[64 * j]; s += (v[j].x + v[j].y) + (v[j].z + v[j].w); }
        const float mean = wave_sum(s) * (1.f / D); float q = 0.f;
#pragma unroll
        for (int j = 0; j < 4; ++j) { v[j] = v[j] - mean; q += (v[j].x * v[j].x + v[j].y * v[j].y) + (v[j].z * v[j].z + v[j].w * v[j].w); }
        const float rstd = rsqrtf(wave_sum(q) * (1.f / D) + LN_EPS);
        f32x4* xo = (f32x4*)(X1 + (size_t)m * D) + C.lane; unsigned long long* ho = (unsigned long long*)(H2 + (size_t)m * D) + C.lane;
#pragma unroll
        for (int j = 0; j < 4; ++j) { const f32x4 x1 = v[j] * rstd * ((const f32x4*)ln1_g)[C.lane + 64 * j] + ((const f32x4*)ln1_b)[C.lane + 64 * j]; xo[64 * j] = x1;
            const f32x4 h2 = x1 * (sc2[64 * j] + 1.0f) + sh2[64 * j]; ho[64 * j] = (unsigned long long)pk2(h2.x, h2.y) | ((unsigned long long)pk2(h2.z, h2.w) << 32); }
    }
}
__device__ __forceinline__ int fkey(float f) { const int b = __builtin_bit_cast(int, f); return b ^ ((b >> 31) & 0x7fffffff); }
__device__ __forceinline__ float kfloat(int k) { const int b = k ^ ((k >> 31) & 0x7fffffff); return __builtin_bit_cast(float, b); }
template <int N> __device__ __forceinline__ void sort16_groups_desc(int (&v)[N]) {
#pragma unroll
    for (int ks = 1; ks <= 4; ++ks)
#pragma unroll
        for (int js = ks - 1; js >= 0; --js)
#pragma unroll
            for (int i = 0; i < N; ++i) { const int k = 1 << ks, j = 1 << js, l = i ^ j;
                if (l > i) { const bool desc = ((i & 15 & k) == 0); const int mx = max(v[i], v[l]), mn = min(v[i], v[l]); v[i] = desc ? mx : mn; v[l] = desc ? mn : mx; } }
}
template <int OA, int OB, int N> __device__ __forceinline__ void merge_top16(int (&v)[N]) {
#pragma unroll
    for (int i = 0; i < 16; ++i) v[OA + i] = max(v[OA + i], v[OB + 15 - i]);
#pragma unroll
    for (int js = 3; js >= 0; --js)
#pragma unroll
        for (int i = 0; i < 16; ++i) { const int j = 1 << js, l = i ^ j; if (l > i) { const int mx = max(v[OA + i], v[OA + l]), mn = min(v[OA + i], v[OA + l]); v[OA + i] = mx; v[OA + l] = mn; } }
}
__device__ __forceinline__ void top16_of_64(int (&v)[64]) { sort16_groups_desc<64>(v); merge_top16<0, 16, 64>(v); merge_top16<32, 48, 64>(v); merge_top16<0, 32, 64>(v); }
constexpr int cand_n(int a) { return a == 0 ? 16 : 16 / (a + 1); }
constexpr int cand_off(int a) { int s = 0; for (int i = 0; i < a; ++i) s += cand_n(i); return s; }
static_assert(cand_off(16) == 50, "staircase candidate count");

__device__ __forceinline__ void route_item(const bf16* Q, const bf16* SUBK, int* IDX, float* GATE, int tg, int h, LAS unsigned char* slot, int lane) {
    const int col = lane & 31, hi = lane >> 5, t = tg * 32 + col;
    LAS int* tl = (LAS int*)slot + lane;
#pragma unroll 1
    for (int p = 0; p < 2; ++p) {
        f32x16 acc[4];
#pragma unroll
        for (int kt = 0; kt < 4; ++kt)
#pragma unroll
            for (int r = 0; r < 16; ++r) acc[kt][r] = 0.f;
        const bf16* qrow = Q + (size_t)t * NQ + h * 256 + p * 128 + 8 * hi;
        const bf16* kb = SUBK + ((size_t)(h * 2 + p) * NKEYS + col) * 128 + 8 * hi;
#pragma unroll
        for (int ks = 0; ks < 8; ++ks) { const bf16x8 bq = *(const bf16x8*)(qrow + ks * 16);
#pragma unroll
            for (int kt = 0; kt < 4; ++kt) { const bf16x8 ak = *(const bf16x8*)(kb + (size_t)kt * 32 * 128 + ks * 16); acc[kt] = __builtin_amdgcn_mfma_f32_32x32x16_bf16(ak, bq, acc[kt], 0, 0, 0); } }
        int v[64];
#pragma unroll
        for (int kt = 0; kt < 4; ++kt)
#pragma unroll
            for (int r = 0; r < 16; ++r) { const int n = kt * 32 + 8 * (r >> 2) + (r & 3) + 4 * hi; v[kt * 16 + r] = (fkey(acc[kt][r]) & ~0x7F) | n; }
        top16_of_64(v);
#pragma unroll
        for (int i = 0; i < 16; ++i) v[16 + i] = __shfl_xor(v[i], 32);
        merge_top16<0, 16, 64>(v);
#pragma unroll
        for (int i = 0; i < 16; ++i) tl[(p * 16 + i) * 64] = v[i];
    }
    int c[64];
    {
        float s1[16], s2[16];
#pragma unroll
        for (int i = 0; i < 16; ++i) { s1[i] = kfloat(tl[i * 64] & ~0x7F); s2[i] = kfloat(tl[(16 + i) * 64] & ~0x7F); }
#pragma unroll
        for (int a = 0; a < 16; ++a)
#pragma unroll
            for (int b = 0; b < 16; ++b) if (b < cand_n(a)) c[cand_off(a) + b] = (fkey(s1[a] + s2[b]) & ~0xFF) | (a * 16 + b);
    }
#pragma unroll
    for (int i = 50; i < 64; ++i) c[i] = (int)0x80000000;
    top16_of_64(c);
    const float mx = kfloat(c[0] & ~0xFF);
    float ev[16]; float sum = 0.f; int id[16];
#pragma unroll
    for (int i = 0; i < 16; ++i) { ev[i] = __expf(kfloat(c[i] & ~0xFF) - mx); sum += ev[i]; const int ab = c[i] & 0xFF; id[i] = (tl[(ab >> 4) * 64] & 0x7F) * NKEYS + (tl[(16 + (ab & 15)) * 64] & 0x7F); }
    const float inv = 1.f / sum;
    if (hi == 0) { int* dst = IDX + ((size_t)t * PH + h) * TOPK;
#pragma unroll
        for (int q4 = 0; q4 < 4; ++q4) { v4u o; o.x = (unsigned)id[4 * q4]; o.y = (unsigned)id[4 * q4 + 1]; o.z = (unsigned)id[4 * q4 + 2]; o.w = (unsigned)id[4 * q4 + 3]; *(v4u*)(dst + 4 * q4) = o; }
    } else { float* dst = GATE + ((size_t)t * PH + h) * TOPK;
#pragma unroll
        for (int q4 = 0; q4 < 4; ++q4) { f32x4 o; o.x = ev[4 * q4] * inv; o.y = ev[4 * q4 + 1] * inv; o.z = ev[4 * q4 + 2] * inv; o.w = ev[4 * q4 + 3] * inv; *(f32x4*)(dst + 4 * q4) = o; }
    }
}
__device__ __forceinline__ void route_phase(const Ctx& C) {
    unsigned char* ws = ARG_WS;
    const bf16* Q = (const bf16*)ARG_OUT; const bf16* SUBK = (const bf16*)(ws + WS_SUBK); int* IDX = (int*)(ws + WS_IDX); float* GATE = (float*)(ws + WS_GATE);
    for (int item = C.gw; item < (M / 32) * PH; item += C.NGW) route_item(Q, SUBK, IDX, GATE, item >> 3, item & 7, C.lds + C.wave * 8192, C.lane);
}
__device__ __forceinline__ void unpack8(const v4u p, float* f) { f[0] = bflo(p.x); f[1] = bfhi(p.x); f[2] = bflo(p.y); f[3] = bfhi(p.y); f[4] = bflo(p.z); f[5] = bfhi(p.z); f[6] = bflo(p.w); f[7] = bfhi(p.w); }
__device__ __forceinline__ void unpack_fp8x16(const v4u p, float* f) {
#pragma unroll
    for (int q = 0; q < 4; ++q) { const f32x2 lo = __builtin_amdgcn_cvt_pk_f32_fp8((int)p[q], false), hi = __builtin_amdgcn_cvt_pk_f32_fp8((int)p[q], true); f[4 * q] = lo.x; f[4 * q + 1] = lo.y; f[4 * q + 2] = hi.x; f[4 * q + 3] = hi.y; }
}
#define PEER_GROUP(idreg, greg, jbase)                                                                                         \
    {                                                                                                                          \
        int e_[4]; float gg_[4]; v4u ua_[4], va_[4];                                                                           \
        _Pragma("unroll") for (int i = 0; i < 4; ++i) { e_[i] = __builtin_amdgcn_readlane(idreg, (jbase) + i); gg_[i] = __builtin_bit_cast(float, __builtin_amdgcn_readlane(__builtin_bit_cast(int, greg), (jbase) + i)); } \
        _Pragma("unroll") for (int i = 0; i < 4; ++i) ua_[i] = *(const v4u*)(PU + (size_t)e_[i] * D + lane * 16);            \
        _Pragma("unroll") for (int i = 0; i < 4; ++i) va_[i] = *(const v4u*)(PV + (size_t)e_[i] * D + lane * 16);            \
        float dt_[4];                                                                                                          \
        _Pragma("unroll") for (int i = 0; i < 4; ++i) { float f_[16]; unpack_fp8x16(ua_[i], f_); float s_ = 0.f;              \
            _Pragma("unroll") for (int k = 0; k < 16; ++k) s_ += f_[k] * hv[k]; dt_[i] = s_; }                                 \
        _Pragma("unroll") for (int o = 1; o < 64; o <<= 1) { _Pragma("unroll") for (int i = 0; i < 4; ++i) dt_[i] += __shfl_xor(dt_[i], o); }                                                                          \
        _Pragma("unroll") for (int i = 0; i < 4; ++i) { const float a_ = gelu_f(dt_[i] * (1.f / PU_SCALE)) * gg_[i] * (1.f / PV_SCALE); float f_[16]; unpack_fp8x16(va_[i], f_);                                      \
            _Pragma("unroll") for (int k = 0; k < 16; ++k) acc[k] += a_ * f_[k]; }                                             \
    }
__device__ __forceinline__ void peer_phase(const Ctx& C) {
    unsigned char* ws = ARG_WS; float* out = ARG_OUT; const float* ln2_g = ARGF(A_LN2G); const float* ln2_b = ARGF(A_LN2B);
    const float* mod = (const float*)(ws + WS_MOD); const bf16* H2 = (const bf16*)(ws + WS_H2); const unsigned char* PU = ws + WS_PU; const unsigned char* PV = ws + WS_PV;
    const int* IDX = (const int*)(ws + WS_IDX); const float* GATE = (const float*)(ws + WS_GATE); const float* X1 = (const float*)(ws + WS_X1);
    const int lane = C.lane;
    for (int t = C.gw; t < M; t += C.NGW) {
        const int b = t / SEQ; const float* mrow = mod + b * 6 * D;
        float hv[16];
        { const v4u p0 = *(const v4u*)(H2 + (size_t)t * D + lane * 16), p1 = *(const v4u*)(H2 + (size_t)t * D + lane * 16 + 8); unpack8(p0, hv); unpack8(p1, hv + 8); }
        const int id0 = IDX[(size_t)t * 128 + lane], id1 = IDX[(size_t)t * 128 + 64 + lane];
        const float g0 = GATE[(size_t)t * 128 + lane], g1 = GATE[(size_t)t * 128 + 64 + lane];
        float acc[16];
#pragma unroll
        for (int k = 0; k < 16; ++k) acc[k] = 0.f;
        for (int jb = 0; jb < 64; jb += 4) PEER_GROUP(id0, g0, jb)
        for (int jb = 0; jb < 64; jb += 4) PEER_GROUP(id1, g1, jb)
        float v[16]; float s = 0.f;
#pragma unroll
        for (int q4 = 0; q4 < 4; ++q4) { const int cidx = lane * 16 + q4 * 4; const f32x4 xv = *(const f32x4*)(X1 + (size_t)t * D + cidx); const f32x4 g2 = *(const f32x4*)(mrow + 5 * D + cidx); const int k = q4 * 4;
            v[k] = ALPHA * xv.x + (1.f + g2.x) * acc[k]; v[k + 1] = ALPHA * xv.y + (1.f + g2.y) * acc[k + 1]; v[k + 2] = ALPHA * xv.z + (1.f + g2.z) * acc[k + 2]; v[k + 3] = ALPHA * xv.w + (1.f + g2.w) * acc[k + 3];
            s += (v[k] + v[k + 1]) + (v[k + 2] + v[k + 3]); }
        const float mean = wave_sum(s) * (1.f / D); float q = 0.f;
#pragma unroll
        for (int k = 0; k < 16; ++k) { v[k] -= mean; q += v[k] * v[k]; }
        const float rstd = rsqrtf(wave_sum(q) * (1.f / D) + LN_EPS);
#pragma unroll
        for (int q4 = 0; q4 < 4; ++q4) { const int cidx = lane * 16 + q4 * 4; const f32x4 gg = *(const f32x4*)(ln2_g + cidx), bb = *(const f32x4*)(ln2_b + cidx); const int k = q4 * 4;
            f32x4 o; o.x = v[k] * rstd * gg.x + bb.x; o.y = v[k + 1] * rstd * gg.y + bb.y; o.z = v[k + 2] * rstd * gg.z + bb.z; o.w = v[k + 3] * rstd * gg.w + bb.w;
            *(f32x4*)(out + (size_t)t * D + cidx) = o; }
    }
}
#ifndef MK_N_LAUNCHES
#define MK_N_LAUNCHES 1
#endif
constexpr int NPH = 11;
constexpr int N_LAUNCHES = MK_N_LAUNCHES;
static_assert(N_LAUNCHES == 1 || N_LAUNCHES == NPH, "MK_N_LAUNCHES is 1 or NPH");

struct Args { const float* in[18]; float* out; unsigned char* ws; int ph_lo, ph_hi; };

__global__ void __launch_bounds__(NTHR, 2) mk_fwd(Args args) {
    extern __shared__ __attribute__((aligned(16))) unsigned char lds_raw[];
    Ctx C;
    C.lds = (LAS unsigned char*)lds_raw;
    C.tid = threadIdx.x; C.lane = C.tid & 63; C.wave = __builtin_amdgcn_readfirstlane(C.tid >> 6);
    C.wg = blockIdx.x; C.G = gridDim.x; C.gw = C.wg * NWAVES + C.wave; C.NGW = C.G * NWAVES;
    volatile LAS unsigned* MISC = (volatile LAS unsigned*)(C.lds + MISC_OFF);
    for (int u = C.tid; u < (LDS_BYTES - LDSCTL_OFF) / 4; u += NTHR) ((LAS unsigned*)(C.lds + LDSCTL_OFF))[u] = 0u;
    __syncthreads();
    if (C.tid < A_COUNT) {
        const unsigned long long v = (C.tid < 18) ? (unsigned long long)args.in[C.tid < 18 ? C.tid : 0] : (C.tid == A_OUT ? (unsigned long long)args.out : (unsigned long long)args.ws);
        ((LAS unsigned long long*)(C.lds + ARGT_OFF))[C.tid] = v;
    }
    __syncthreads();
    unsigned* ctl = (unsigned*)(ARG_WS + WS_CTL);
    XcdBarrier bar; bar.bar = ctl + CW_BAR; bar.x = 0; bar.st = nullptr;
    if (N_LAUNCHES == 1) bar = xcd_barrier_post(ctl + CW_BAR, MISC + 8);
    const int lo = args.ph_lo, hi = args.ph_hi;
#ifndef PROBE_DUP
#define PROBE_DUP 0
#endif
#define IN(k) (lo <= (k) && (k) < hi)
#define REP(k) for (int rep_ = 0; rep_ < 1 + ((PROBE_DUP >> (k)) & 1); ++rep_)
#define SEAM(k) do { if (IN(k) && IN((k) + 1)) xcd_barrier(bar); } while (0)

    if (IN(0)) REP(0) { phase0(C); } SEAM(0);
    if (IN(1)) REP(1) { phase0b(C); } SEAM(1);
    if (IN(2)) REP(2) {
        pg8::Gemm g{(const pg8::bf16_t*)(ARG_WS + WS_H), (const pg8::bf16_t*)(ARG_WS + WS_WIN), M, NPROJ, D}; pg8::StaticOrder S; S.init(M, NPROJ, C.G, C.wg);
        pg8::EpiBf16<0> E{(pg8::bf16_t*)(ARG_WS + WS_PROJ), NPROJ, nullptr, 0, 0, 1.f};
        pg8::gemm_phase<pg8::EpiBf16<0>, pg8::StaticOrder, true, true>(C.lds, g, S, E);
        glr_simple(C);
    } SEAM(2);
    if (IN(3)) REP(3) { conv_phase(C); gla_pass_a(C); } SEAM(3);
    if (IN(4)) REP(4) { gla_scan(C); } SEAM(4);
    if (IN(5)) REP(5) { gla_pass_c(C); } SEAM(5);
    if (IN(6)) REP(6) {
        pg8::Gemm g{(const pg8::bf16_t*)(ARG_WS + WS_H), (const pg8::bf16_t*)(ARG_WS + WS_WOUT), M, D, D}; pg8::StaticOrder S; S.init(M, D, C.G, C.wg);
        EpiF32 E{ARG_OUT, D};
        pg8::gemm_phase<EpiF32, pg8::StaticOrder, true, true>(C.lds, g, S, E);
    } SEAM(6);
    if (IN(7)) REP(7) { ln1_phase(C); } SEAM(7);
    if (IN(8)) REP(8) {
        pg8::Gemm g{(const pg8::bf16_t*)(ARG_WS + WS_H2), (const pg8::bf16_t*)(ARG_WS + WS_WQ), M, NQ, D}; pg8::StaticOrder S; S.init(M, NQ, C.G, C.wg);
        pg8::EpiBf16<0> E{(pg8::bf16_t*)ARG_OUT, NQ, nullptr, 0, 0, 1.f};
        pg8::gemm_phase<pg8::EpiBf16<0>, pg8::StaticOrder, true, true>(C.lds, g, S, E);
    } SEAM(8);
    if (IN(9)) REP(9) { route_phase(C); } SEAM(9);
    if (IN(10)) REP(10) { peer_phase(C); }
#undef IN
#undef SEAM
}

extern "C" void kernel_launch(void* const* d_in, const int* in_sizes, int n_in, void* d_out, int out_size, void* d_ws, size_t ws_size, hipStream_t stream) {
    static int grid = 0;
    if (grid == 0) {
        int dev = 0, cus = 0;
        if (n_in != 18 || out_size != M * D || ws_size < 256 * MiB) { fprintf(stderr, "kernel_launch: unexpected problem (n_in %d out %d ws %zu)\n", n_in, out_size, ws_size); grid = -1; return; }
        if (hipGetDevice(&dev) != hipSuccess || hipDeviceGetAttribute(&cus, hipDeviceAttributeMultiprocessorCount, dev) != hipSuccess) { grid = -1; return; }
        if (hipFuncSetAttribute((const void*)mk_fwd, hipFuncAttributeMaxDynamicSharedMemorySize, LDS_BYTES) != hipSuccess) { fprintf(stderr, "kernel_launch: hipFuncSetAttribute failed\n"); grid = -1; return; }
        int per_cu = 0;
        (void)hipOccupancyMaxActiveBlocksPerMultiprocessor(&per_cu, (const void*)mk_fwd, NTHR, LDS_BYTES);
        (void)hipGetLastError();
        if (per_cu < 1) fprintf(stderr, "kernel_launch: occupancy query reports %d blocks per CU\n", per_cu);
        grid = cus;
    }
    if (grid < 0) return;
    (void)hipMemsetAsync((char*)d_ws + WS_CTL, 0, CTL_ZERO_BYTES, stream);
    Args a{};
    for (int i = 0; i < 18; ++i) a.in[i] = (const float*)d_in[i];
    a.out = (float*)d_out; a.ws = (unsigned char*)d_ws;
    for (int li = 0; li < N_LAUNCHES; ++li) {
        a.ph_lo = (N_LAUNCHES == 1) ? 0 : li; a.ph_hi = (N_LAUNCHES == 1) ? NPH : li + 1;
        hipLaunchKernelGGL(mk_fwd, dim3(grid), dim3(NTHR), LDS_BYTES, stream, a);
    }
}
```

```cpp
#include <hip/hip_runtime.h>
#include <cstdio>
#include <cstdint>
#include <cmath>
namespace pg8 {
#define PG8_LAS __attribute__((address_space(3)))
typedef unsigned short bf16_t;
typedef short bf16x8 __attribute__((ext_vector_type(8)));
typedef float f32x4 __attribute__((ext_vector_type(4)));
typedef unsigned u32x4 __attribute__((ext_vector_type(4)));
constexpr int BM = 256, BK = 64, HALF = 128, HTB = HALF * BK * 2  , STAGE_BYTES = 8 * HTB, NXCD = 8, WGM = 8;

__host__ __device__ __forceinline__ int lds_byte(int r, int c) { const int st = (r >> 4) * 2 + (c >> 5), rr = r & 15, cc = c & 31, ob = rr * 64 + cc * 2; return st * 1024 + (ob ^ (((ob >> 9) & 1) << 5)); }
__host__ __device__ __forceinline__ void stage_rc(int b, int& R, int& C) { const int st = b / 1024, sb = b % 1024, swz = sb ^ (((sb >> 9) & 1) << 5); R = (st >> 1) * 16 + swz / 64; C = (st & 1) * 32 + (swz % 64) / 2; }
__host__ __device__ __forceinline__ int perm32(int rho) { const int n = rho >> 4, i = rho & 15; return 8 * (i >> 2) + 4 * n + (i & 3); }

struct Unit { int pm, pn; };
struct Gemm { const bf16_t* A; const bf16_t* Bt; int M, N, K; };

struct StaticOrder {
    int nM, nN, nwg, G, c;
    __host__ __device__ void init(int M, int N, int G_, int c_) { nM = M / BM; nN = N / BM; nwg = nM * nN; G = G_; c = c_; }
    __host__ __device__ bool next(int i, Unit& u) const {
        const long L = (long)i * G + c; if (L >= nwg) return false;
        int wgid = (int)L; { const int q = nwg / NXCD, r = nwg % NXCD, xcd = wgid % NXCD, off = wgid / NXCD; wgid = (xcd < r ? xcd * (q + 1) : r * (q + 1) + (xcd - r) * q) + off; }
        const int nig = WGM * nN, gid = wgid / nig, fm = gid * WGM, gsz = (nM - fm) < WGM ? (nM - fm) : WGM;
        u.pm = fm + ((wgid % nig) % gsz); u.pn = (wgid % nig) / gsz; return true;
    }
    __device__ __forceinline__ void a_ready(const Unit&) const {}
    __device__ __forceinline__ void done(const Unit&) const {}
};

__device__ __forceinline__ unsigned cvt_pk_bf16(float lo, float hi) { unsigned r; asm volatile("v_cvt_pk_bf16_f32 %0, %1, %2" : "=v"(r) : "v"(lo), "v"(hi)); return r; }
typedef float f32x2 __attribute__((ext_vector_type(2)));
__device__ __forceinline__ f32x2 gelu_pk(f32x2 v) {
    const f32x2 av = __builtin_elementwise_abs(v), d = av * 0.2316418882f + 1.0f;
    f32x2 t; t.x = __builtin_amdgcn_rcpf(d.x); t.y = __builtin_amdgcn_rcpf(d.y);
    f32x2 q = t * 0.5307027145f + (-0.7265760135f); q = q * t + 0.7107068705f; q = q * t + (-0.142248368f); q = q * t + 0.127414796f; q = q * t;
    const f32x2 s = (v * v) * (-0.72134752044f);
    f32x2 e; e.x = __builtin_amdgcn_exp2f(s.x); e.y = __builtin_amdgcn_exp2f(s.y);
    const f32x2 m = v * (q * e), r = v - m;
    f32x2 o; o.x = v.x < 0.f ? m.x : r.x; o.y = v.y < 0.f ? m.y : r.y; return o;
}

template <int ACT  > struct EpiBf16 {
    static constexpr bool PERM = true, AFTER_DRAIN = false; static_assert(ACT == 0 || ACT == 1, "EpiBf16: ACT is 0 (none) or 1 (gelu_pk)");
    bf16_t* O; int ldc; const float* bias; int split_cols; size_t split_stride; float scale0;
    __device__ __forceinline__ void operator()(const f32x4 (&acc)[2][2][4][2], const Unit& u, int wr, int wc, int fr, int fq) const {
        const int row0 = u.pm * BM + wr * 64 + fr; int colt = u.pn * BM; bf16_t* base = O;
        float sc = 1.f; if (split_cols) { const int t = colt / split_cols; base += (size_t)t * split_stride; colt -= t * split_cols; if (t == 0) sc = scale0; }
        const int col0 = colt + wc * 32 + 8 * fq, bcol0 = u.pn * BM + wc * 32 + 8 * fq;
        f32x4 bv[2][2];
#pragma unroll
        for (int bj = 0; bj < 2; ++bj)
#pragma unroll
            for (int n = 0; n < 2; ++n) bv[bj][n] = bias ? *(const f32x4*)(bias + bcol0 + bj * HALF + 4 * n) : (f32x4){0.f, 0.f, 0.f, 0.f};
#pragma unroll
        for (int ai = 0; ai < 2; ++ai)
#pragma unroll
            for (int m = 0; m < 4; ++m) { bf16_t* rowp = base + (size_t)(row0 + ai * HALF + m * 16) * ldc + col0;
#pragma unroll
                for (int bj = 0; bj < 2; ++bj) { f32x4 v0 = acc[ai][bj][m][0] + bv[bj][0], v1 = acc[ai][bj][m][1] + bv[bj][1];
                    if (ACT == 1) { f32x2 a = gelu_pk((f32x2){v0[0], v0[1]}), b = gelu_pk((f32x2){v0[2], v0[3]}), c = gelu_pk((f32x2){v1[0], v1[1]}), d = gelu_pk((f32x2){v1[2], v1[3]});
                        v0 = (f32x4){a.x, a.y, b.x, b.y}; v1 = (f32x4){c.x, c.y, d.x, d.y}; }
                    v0 = v0 * sc; v1 = v1 * sc; u32x4 w; w.x = cvt_pk_bf16(v0[0], v0[1]); w.y = cvt_pk_bf16(v0[2], v0[3]); w.z = cvt_pk_bf16(v1[0], v1[1]); w.w = cvt_pk_bf16(v1[2], v1[3]);
                    *(u32x4*)(rowp + bj * HALF) = w; } }
    }
};

struct PanelStats {
    unsigned* xbuf;
    unsigned* cnt;
    unsigned* tmo;
    int ntn; float eps;
    unsigned code;
    __device__ __forceinline__ bool run(const f32x4 (&v)[2][2][4][2], const Unit& u, int wr, int wc, int fr, int fq, PG8_LAS unsigned char* lds, int wid, int lane) const {
        typedef float f32x2v __attribute__((ext_vector_type(2)));
        PG8_LAS f32x2v* P = (PG8_LAS f32x2v*)lds;
        PG8_LAS f32x2v* S = (PG8_LAS f32x2v*)(lds + 8192);
        PG8_LAS unsigned* flag = (PG8_LAS unsigned*)(lds + 8192 + 2048);
#pragma unroll
        for (int ai = 0; ai < 2; ++ai)
#pragma unroll
            for (int m = 0; m < 4; ++m) {
                float s = 0.f;
#pragma unroll
                for (int bj = 0; bj < 2; ++bj)
#pragma unroll
                    for (int n = 0; n < 2; ++n) { const f32x4 x = v[ai][bj][m][n]; s += (x[0] + x[1]) + (x[2] + x[3]); }
                s += __shfl_xor(s, 16); s += __shfl_xor(s, 32);
                const float mw = s * (1.0f / 64.0f); float q = 0.f;
#pragma unroll
                for (int bj = 0; bj < 2; ++bj)
#pragma unroll
                    for (int n = 0; n < 2; ++n) { const f32x4 d = v[ai][bj][m][n] - mw; q += (d[0] * d[0] + d[1] * d[1]) + (d[2] * d[2] + d[3] * d[3]); }
                q += __shfl_xor(q, 16); q += __shfl_xor(q, 32);
                if (fq == 0) P[(ai * HALF + wr * 64 + m * 16 + fr) * 4 + wc] = (f32x2v){mw, q};
            }
        asm volatile("s_waitcnt lgkmcnt(0)" ::: "memory"); __builtin_amdgcn_s_barrier(); asm volatile("" ::: "memory");
#if defined(BROKEN_EXCHANGE_NO_WAIT)
#warning BROKEN CONTROL BUILD: the row-statistics exchange does not wait; results are wrong by design
        if (blockIdx.x >= 64) { const long long t0_ = clock64(); while (clock64() - t0_ < 60000) __builtin_amdgcn_s_sleep(8); }
#endif
        const int row = wid * 32 + (lane & 31);
        if (lane < 32) {
            const f32x2v a = P[row * 4 + 0], b = P[row * 4 + 1], c = P[row * 4 + 2], d = P[row * 4 + 3];
            const float mt = (a.x + b.x + c.x + d.x) * 0.25f;
            const float da = a.x - mt, db = b.x - mt, dc = c.x - mt, dd = d.x - mt;
            const float m2 = (a.y + b.y) + (c.y + d.y) + 64.0f * ((da * da + db * db) + (dc * dc + dd * dd));
            unsigned long long* slot = (unsigned long long*)xbuf + ((size_t)(u.pm * BM + row) * 4 + u.pn);
            __hip_atomic_store(slot, ((unsigned long long)__float_as_uint(m2) << 32) | __float_as_uint(mt), __ATOMIC_RELAXED, __HIP_MEMORY_SCOPE_AGENT);
        }
        asm volatile("s_waitcnt vmcnt(0)" ::: "memory");
        if (lane == 0) __hip_atomic_fetch_add(cnt + 64 * u.pm, 1u, __ATOMIC_RELAXED, __HIP_MEMORY_SCOPE_AGENT);
        if (wid == 0) {
            bool dead = false; const unsigned long long t0 = __builtin_amdgcn_s_memrealtime(); const unsigned want = 8u * (unsigned)ntn;
            for (;;) {
#if defined(BROKEN_EXCHANGE_NO_WAIT)
                break;
#endif
                if ((unsigned)__builtin_amdgcn_readfirstlane(__hip_atomic_load(cnt + 64 * u.pm, __ATOMIC_RELAXED, __HIP_MEMORY_SCOPE_AGENT)) >= want) break;
                if (__builtin_amdgcn_s_memrealtime() - t0 > 2000000ull) {
                    if (lane == 0) { unsigned expect = 0u; __hip_atomic_compare_exchange_strong(tmo + 1, &expect, code | (unsigned)(u.pm & 0xff), __ATOMIC_RELAXED, __ATOMIC_RELAXED, __HIP_MEMORY_SCOPE_AGENT);
                                     __hip_atomic_store(tmo, 1u, __ATOMIC_RELAXED, __HIP_MEMORY_SCOPE_AGENT); }
                    dead = true; break; }
                __builtin_amdgcn_s_sleep(2);
            }
            __builtin_amdgcn_fence(__ATOMIC_ACQUIRE, "agent");
            if (lane == 0) flag[0] = dead ? 1u : 0u;
        }
        asm volatile("s_waitcnt vmcnt(0) lgkmcnt(0)" ::: "memory"); __builtin_amdgcn_s_barrier(); asm volatile("" ::: "memory");
        const bool bad = flag[0] != 0u;
        if (lane < 32) {
            const unsigned long long* slot = (const unsigned long long*)xbuf + (size_t)(u.pm * BM + row) * 4; float mt[4], m2[4]; float ms = 0.f;
#pragma unroll
            for (int t = 0; t < 4; ++t) { if (t < ntn) { const unsigned long long w = __hip_atomic_load(slot + t, __ATOMIC_RELAXED, __HIP_MEMORY_SCOPE_AGENT); mt[t] = __uint_as_float((unsigned)w); m2[t] = __uint_as_float((unsigned)(w >> 32)); } else { mt[t] = 0.f; m2[t] = 0.f; } ms += mt[t]; }
            const float mean = ms / (float)ntn; float q = 0.f;
#pragma unroll
            for (int t = 0; t < 4; ++t) if (t < ntn) { const float dm = mt[t] - mean; q += m2[t] + 256.0f * dm * dm; }
            S[row] = (f32x2v){mean, 1.0f / sqrtf(q / (256.0f * (float)ntn) + eps)};
        }
        asm volatile("s_waitcnt lgkmcnt(0)" ::: "memory"); __builtin_amdgcn_s_barrier(); asm volatile("" ::: "memory");
        return bad;
    }
};
struct EpiLnRes {
    static constexpr bool PERM = false, AFTER_DRAIN = true;
    const float* base; float* out; int ldc; const float* bias; PanelStats st; unsigned poison;
    __device__ __forceinline__ void fused(f32x4 (&acc)[2][2][4][2], const Unit& u, int wr, int wc, int fr, int fq, PG8_LAS unsigned char* lds, int wid, int lane) const {
        typedef float f32x2v __attribute__((ext_vector_type(2)));
        const PG8_LAS f32x2v* S = (const PG8_LAS f32x2v*)(lds + 8192);
        const int col0 = u.pn * BM + wc * 32 + 4 * fq;
#pragma unroll
        for (int bj = 0; bj < 2; ++bj)
#pragma unroll
            for (int n = 0; n < 2; ++n) { const f32x4 bv = bias ? *(const f32x4*)(bias + col0 + bj * HALF + n * 16) : (f32x4){0.f, 0.f, 0.f, 0.f};
#pragma unroll
                for (int ai = 0; ai < 2; ++ai)
#pragma unroll
                    for (int m = 0; m < 4; ++m) acc[ai][bj][m][n] += bv; }
        f32x4 pre[4][2][2];
#pragma unroll
        for (int m = 0; m < 4; ++m) { const size_t off = (size_t)(u.pm * BM + wr * 64 + m * 16 + fr) * ldc + col0;
#pragma unroll
            for (int bj = 0; bj < 2; ++bj)
#pragma unroll
                for (int n = 0; n < 2; ++n) pre[m][bj][n] = *(const f32x4*)(base + off + bj * HALF + n * 16); }
        const bool bad = st.run(acc, u, wr, wc, fr, fq, lds, wid, lane) || poison != 0u;
        const float qnan = __builtin_nanf("");
#pragma unroll
        for (int ai = 0; ai < 2; ++ai)
#pragma unroll
            for (int m = 0; m < 4; ++m) { const int r = ai * HALF + wr * 64 + m * 16 + fr; const f32x2v sr = S[r]; const size_t off = (size_t)(u.pm * BM + r) * ldc + col0;
#pragma unroll
                for (int bj = 0; bj < 2; ++bj)
#pragma unroll
                    for (int n = 0; n < 2; ++n) { const f32x4 bs = ai == 0 ? pre[m][bj][n] : *(const f32x4*)(base + off + bj * HALF + n * 16); f32x4 o = bs + (acc[ai][bj][m][n] - sr.x) * sr.y;
                        if (bad) o = (f32x4){qnan, qnan, qnan, qnan}; *(f32x4*)(out + off + bj * HALF + n * 16) = o; }
                if (m & 1) asm volatile("" ::: "memory"); }
    }
};
struct EpiLnResLn {
    static constexpr bool PERM = false, AFTER_DRAIN = true;
    const float* base; float* out; bf16_t* xn; int ldc; const float* bias; PanelStats st1, st2; unsigned poison;
    __device__ __forceinline__ void fused(f32x4 (&acc)[2][2][4][2], const Unit& u, int wr, int wc, int fr, int fq, PG8_LAS unsigned char* lds, int wid, int lane) const {
        typedef float f32x2v __attribute__((ext_vector_type(2))); typedef unsigned u32x2v __attribute__((ext_vector_type(2)));
        const PG8_LAS f32x2v* S = (const PG8_LAS f32x2v*)(lds + 8192);
        const int col0 = u.pn * BM + wc * 32 + 4 * fq;
#pragma unroll
        for (int bj = 0; bj < 2; ++bj)
#pragma unroll
            for (int n = 0; n < 2; ++n) { const f32x4 bv = bias ? *(const f32x4*)(bias + col0 + bj * HALF + n * 16) : (f32x4){0.f, 0.f, 0.f, 0.f};
#pragma unroll
                for (int ai = 0; ai < 2; ++ai)
#pragma unroll
                    for (int m = 0; m < 4; ++m) acc[ai][bj][m][n] += bv; }
        bool bad = st1.run(acc, u, wr, wc, fr, fq, lds, wid, lane) || poison != 0u;
        const float qnan = __builtin_nanf("");
#pragma unroll
        for (int ai = 0; ai < 2; ++ai)
#pragma unroll
            for (int m = 0; m < 4; ++m) { const int r = ai * HALF + wr * 64 + m * 16 + fr; const f32x2v sr = S[r]; const size_t off = (size_t)(u.pm * BM + r) * ldc + col0;
#pragma unroll
                for (int bj = 0; bj < 2; ++bj)
#pragma unroll
                    for (int n = 0; n < 2; ++n) { const f32x4 bs = *(const f32x4*)(base + off + bj * HALF + n * 16); acc[ai][bj][m][n] = bs + (acc[ai][bj][m][n] - sr.x) * sr.y; }
                asm volatile("" : "+v"(acc[ai][0][m][0]), "+v"(acc[ai][0][m][1]), "+v"(acc[ai][1][m][0]), "+v"(acc[ai][1][m][1]));
                if (m & 1) asm volatile("" ::: "memory"); }
        const bool bad1 = bad;
        bad = st2.run(acc, u, wr, wc, fr, fq, lds, wid, lane) || bad;
#pragma unroll
        for (int ai = 0; ai < 2; ++ai)
#pragma unroll
            for (int m = 0; m < 4; ++m) { const int r = ai * HALF + wr * 64 + m * 16 + fr; const f32x2v sr = S[r]; const size_t off = (size_t)(u.pm * BM + r) * ldc + col0;
#pragma unroll
                for (int bj = 0; bj < 2; ++bj)
#pragma unroll
                    for (int n = 0; n < 2; ++n) { const f32x4 x1 = acc[ai][bj][m][n]; *(f32x4*)(out + off + bj * HALF + n * 16) = bad1 ? (f32x4){qnan, qnan, qnan, qnan} : x1;
                        const f32x4 o = (x1 - sr.x) * sr.y; u32x2v w; w.x = cvt_pk_bf16(o[0], o[1]); w.y = cvt_pk_bf16(o[2], o[3]);
                        if (bad) { w.x = 0x7fc07fc0u; w.y = 0x7fc07fc0u; } *(u32x2v*)(xn + off + bj * HALF + n * 16) = w; }
                asm volatile("" ::: "memory"); }
    }
};

template <class Epi, class Sched, bool ALIGN_EPI = false, bool SP2 = false>
__device__ __forceinline__ void gemm_phase(PG8_LAS unsigned char* lds, const Gemm g, const Sched& S, const Epi& E) {
    const int tid = threadIdx.x, wid = __builtin_amdgcn_readfirstlane(tid >> 6), lane = tid & 63, wr = wid >> 2, wc = wid & 3, fr = lane & 15, fq = lane >> 4;
    const int K = g.K, nt = K / BK;
    unsigned voffA[2], voffB[2];
#pragma unroll
    for (int i = 0; i < 2; ++i) { int R, C; stage_rc(tid * 16 + i * 8192, R, C); const int Rb = Epi::PERM ? ((R & ~31) + perm32(R & 31)) : R;
        voffA[i] = (unsigned)(R * K + C) * 2u; voffB[i] = (unsigned)(Rb * K + C) * 2u; }
    const size_t kstep = (size_t)(BK * 2);
    const size_t hstep = (size_t)HALF * K * 2;
    const size_t tstep = 2 * hstep;
    const unsigned ldsw = (unsigned)wid * 1024u;
    const int aoff = lds_byte(wr * 64 + fr, fq * 8), boff = lds_byte(wc * 32 + fr, fq * 8);
#define PG8_SA(b, h) (((b) * 2 + (h)) * HTB)
#define PG8_SB(b, h) ((4 + (b) * 2 + (h)) * HTB)
#define PG8_STAGE(bufoff, gbase, voff) do { _Pragma("unroll") for (int _i = 0; _i < 2; ++_i) \
        __builtin_amdgcn_global_load_lds((const unsigned*)((const char*)(gbase) + (voff)[_i]), (PG8_LAS unsigned*)(lds + (bufoff) + ldsw + _i * 8192), 16, 0, 0); } while (0)
#define PG8_LDA(dst, b, h) do { _Pragma("unroll") for (int m = 0; m < 4; ++m) _Pragma("unroll") for (int k = 0; k < 2; ++k) dst[m][k] = *(const PG8_LAS bf16x8*)(lds + PG8_SA(b, h) + aoff + m * 2048 + k * 1024); } while (0)
#define PG8_LDB(dst, b, h) do { _Pragma("unroll") for (int n = 0; n < 2; ++n) _Pragma("unroll") for (int k = 0; k < 2; ++k) dst[n][k] = *(const PG8_LAS bf16x8*)(lds + PG8_SB(b, h) + boff + n * 2048 + k * 1024); } while (0)
#define PG8_MMA(ai, bj, At, Bt) do { __builtin_amdgcn_s_setprio(1); _Pragma("unroll") for (int m = 0; m < 4; ++m) _Pragma("unroll") for (int n = 0; n < 2; ++n) _Pragma("unroll") for (int k = 0; k < 2; ++k) \
        acc[ai][bj][m][n] = __builtin_amdgcn_mfma_f32_16x16x32_bf16(Bt[n][k], At[m][k], acc[ai][bj][m][n], 0, 0, 0); __builtin_amdgcn_s_setprio(0); } while (0)
#define PG8_WAIT_V(n) asm volatile("s_waitcnt vmcnt(" #n ")" ::: "memory")
#define PG8_WAIT_L(n) asm volatile("s_waitcnt lgkmcnt(" #n ")" ::: "memory")
#define PG8_BAR __builtin_amdgcn_s_barrier()
#define PG8_SCHED __builtin_amdgcn_sched_barrier(0)
    Unit cur, nxt; int ui = 0;
    if (!S.next(0, cur)) return;
    f32x4 acc[2][2][4][2];
#pragma unroll
    for (int a = 0; a < 2; ++a)
#pragma unroll
        for (int b = 0; b < 2; ++b)
#pragma unroll
            for (int m = 0; m < 4; ++m)
#pragma unroll
                for (int n = 0; n < 2; ++n) acc[a][b][m][n] = (f32x4){0.f, 0.f, 0.f, 0.f};
    bf16x8 At[4][2], B0[2][2], B1[2][2];
    const char* cA = (const char*)g.A + (size_t)cur.pm * tstep; const char* cB = (const char*)g.Bt + (size_t)cur.pn * tstep;
    S.a_ready(cur);
    if constexpr (SP2) {
        PG8_STAGE(PG8_SB(0, 0), cB, voffB); PG8_STAGE(PG8_SB(0, 1), cB + hstep, voffB); PG8_STAGE(PG8_SA(0, 0), cA, voffA); PG8_STAGE(PG8_SA(0, 1), cA + hstep, voffA);
        if (wr == 1) PG8_BAR;
        PG8_WAIT_V(2); PG8_BAR;
        PG8_STAGE(PG8_SB(1, 0), cB + kstep, voffB); PG8_STAGE(PG8_SA(1, 0), cA + kstep, voffA); PG8_STAGE(PG8_SB(1, 1), cB + hstep + kstep, voffB);
        PG8_WAIT_V(6); PG8_BAR;
    } else {
        PG8_STAGE(PG8_SB(0, 0), cB, voffB); PG8_STAGE(PG8_SA(0, 0), cA, voffA); PG8_STAGE(PG8_SB(0, 1), cB + hstep, voffB); PG8_STAGE(PG8_SA(0, 1), cA + hstep, voffA);
        if (wr == 1) PG8_BAR;
        PG8_WAIT_V(4); PG8_BAR;
        PG8_STAGE(PG8_SB(1, 0), cB + kstep, voffB); PG8_STAGE(PG8_SA(1, 0), cA + kstep, voffA); PG8_STAGE(PG8_SB(1, 1), cB + hstep + kstep, voffB);
        PG8_WAIT_V(6); PG8_BAR;
    }
    for (;;) {
        const bool has_next = S.next(ui + 1, nxt);
        const char* nA = has_next ? (const char*)g.A + (size_t)nxt.pm * tstep : cA; const char* nB = has_next ? (const char*)g.Bt + (size_t)nxt.pn * tstep : cB;
        for (int t = 0; t < nt; t += 2) {
            const bool last = (t == nt - 2);
            const char* a1 = cA + (size_t)(t + 1) * kstep;
            const char* a2 = last ? nA : cA + (size_t)(t + 2) * kstep; const char* b2 = last ? nB : cB + (size_t)(t + 2) * kstep;
            const char* a3 = a2 + kstep; const char* b3 = b2 + kstep;
            if (last && has_next) S.a_ready(nxt);
            if constexpr (SP2) {
            PG8_LDB(B0, 0, 0); PG8_LDB(B1, 0, 1); PG8_SCHED; PG8_LDA(At, 0, 0); PG8_STAGE(PG8_SA(1, 1), a1 + hstep, voffA);
            PG8_WAIT_V(8); PG8_WAIT_L(0); PG8_BAR; PG8_MMA(0, 0, At, B0); PG8_MMA(0, 1, At, B1); PG8_BAR; PG8_SCHED;
            PG8_LDA(At, 0, 1); PG8_STAGE(PG8_SB(0, 0), b2, voffB); PG8_STAGE(PG8_SB(0, 1), b2 + hstep, voffB); PG8_STAGE(PG8_SA(0, 0), a2, voffA);
            PG8_WAIT_V(8); PG8_WAIT_L(0); PG8_BAR; PG8_MMA(1, 0, At, B0); PG8_MMA(1, 1, At, B1); PG8_BAR; PG8_SCHED;
            PG8_LDB(B0, 1, 0); PG8_LDB(B1, 1, 1); PG8_SCHED; PG8_LDA(At, 1, 0); PG8_STAGE(PG8_SA(0, 1), a2 + hstep, voffA);
            PG8_WAIT_V(8); PG8_WAIT_L(0); PG8_BAR; PG8_MMA(0, 0, At, B0); PG8_MMA(0, 1, At, B1); PG8_BAR; PG8_SCHED;
            PG8_LDA(At, 1, 1); PG8_STAGE(PG8_SB(1, 0), b3, voffB); PG8_STAGE(PG8_SB(1, 1), b3 + hstep, voffB); PG8_STAGE(PG8_SA(1, 0), a3, voffA);
            PG8_WAIT_V(8); PG8_WAIT_L(0); PG8_BAR; PG8_MMA(1, 0, At, B0); PG8_MMA(1, 1, At, B1); PG8_BAR; PG8_SCHED;
            } else {
            PG8_LDB(B0, 0, 0); PG8_SCHED; PG8_LDA(At, 0, 0); PG8_STAGE(PG8_SA(1, 1), a1 + hstep, voffA);
            PG8_WAIT_L(8); PG8_BAR; PG8_WAIT_L(0); PG8_MMA(0, 0, At, B0); PG8_BAR; PG8_SCHED;
            PG8_LDB(B1, 0, 1); PG8_STAGE(PG8_SB(0, 0), b2, voffB);
            PG8_BAR; PG8_WAIT_L(0); PG8_MMA(0, 1, At, B1); PG8_BAR;
            PG8_LDA(At, 0, 1); PG8_STAGE(PG8_SA(0, 0), a2, voffA);
            PG8_BAR; PG8_WAIT_L(0); PG8_MMA(1, 0, At, B0); PG8_BAR; PG8_SCHED;
            PG8_STAGE(PG8_SB(0, 1), b2 + hstep, voffB);
            PG8_WAIT_V(6); PG8_BAR; PG8_MMA(1, 1, At, B1); PG8_BAR;
            PG8_LDB(B0, 1, 0); PG8_SCHED; PG8_LDA(At, 1, 0); PG8_STAGE(PG8_SA(0, 1), a2 + hstep, voffA);
            PG8_WAIT_L(8); PG8_BAR; PG8_WAIT_L(0); PG8_MMA(0, 0, At, B0); PG8_BAR; PG8_SCHED;
            PG8_LDB(B1, 1, 1); PG8_STAGE(PG8_SB(1, 0), b3, voffB);
            PG8_BAR; PG8_WAIT_L(0); PG8_MMA(0, 1, At, B1); PG8_BAR;
            PG8_LDA(At, 1, 1); PG8_STAGE(PG8_SA(1, 0), a3, voffA);
            PG8_BAR; PG8_WAIT_L(0); PG8_MMA(1, 0, At, B0); PG8_BAR; PG8_SCHED;
            PG8_STAGE(PG8_SB(1, 1), b3 + hstep, voffB);
            PG8_WAIT_V(6); PG8_BAR; PG8_MMA(1, 1, At, B1); PG8_BAR;
            }
        }
        if constexpr (ALIGN_EPI) { if (wr == 0) PG8_BAR; }
        if constexpr (!Epi::AFTER_DRAIN) { E(acc, cur, wr, wc, fr, fq); S.done(cur); }
        if (!has_next) break;
#pragma unroll
        for (int a = 0; a < 2; ++a)
#pragma unroll
            for (int b = 0; b < 2; ++b)
#pragma unroll
                for (int m = 0; m < 4; ++m)
#pragma unroll
                    for (int n = 0; n < 2; ++n) acc[a][b][m][n] = (f32x4){0.f, 0.f, 0.f, 0.f};
        cur = nxt; cA = nA; cB = nB; ++ui;
        if constexpr (ALIGN_EPI) { if (wr == 1) PG8_BAR; }
    }
    PG8_WAIT_V(0);
    if constexpr (!ALIGN_EPI) { if (wr == 0) PG8_BAR; }
    PG8_BAR;
    if constexpr (Epi::AFTER_DRAIN) { E.fused(acc, cur, wr, wc, fr, fq, lds, wid, lane); S.done(cur); }
#undef PG8_SA
#undef PG8_SB
#undef PG8_STAGE
#undef PG8_LDA
#undef PG8_LDB
#undef PG8_MMA
#undef PG8_WAIT_V
#undef PG8_WAIT_L
#undef PG8_BAR
#undef PG8_SCHED
}
}
#define LAS __attribute__((address_space(3)))
#define GAS __attribute__((address_space(1)))
#define XB_TMO      128
#define XB_XCNT(j)  (256  + 64 * (j))
#define XB_XSUB(j)  (1280 + 64 * (j))
#define XB_XGEN(j)  (2304 + 64 * (j))
#define XB_TOP      3328
#define XB_TOPGEN   3392
#define XCD_BAR_WORDS 3456
#define XB_SPIN_CAP (1u << 18)
typedef unsigned short bf16;
typedef unsigned v4u __attribute__((ext_vector_type(4)));
typedef unsigned v2u __attribute__((ext_vector_type(2)));
typedef float f32x4 __attribute__((ext_vector_type(4)));
typedef float f32x16 __attribute__((ext_vector_type(16)));
typedef short bf16x8 __attribute__((ext_vector_type(8)));

constexpr int NWAVES = 8, NTHR = 512;
constexpr int D = 1024, BATCH = 8, SEQ = 2048, M = BATCH * SEQ;
constexpr int CONVW = 512, GK = 256, NH = 4, DK = 64, DV = 128, RANK = 16;
constexpr int INC = 3088, NPROJ = 3072;
constexpr int PH = 8, NKEYS = 128, TOPK = 16, NQ = 2048;
constexpr float LN_EPS = 1e-5f, RMS_EPS = 1e-6f;
constexpr float ALPHA = 1.189207115002721f;
constexpr size_t MiB = 1u << 20;
constexpr size_t WS_CTL = 0, CTL_ZERO_BYTES = 1 * MiB;
constexpr size_t WS_MOD = 1 * MiB;
constexpr size_t WS_WIN = 2 * MiB;
constexpr size_t WS_WGLR = 8 * MiB;
constexpr size_t WS_WOUT = 9 * MiB;
constexpr size_t WS_WQ = 11 * MiB;
constexpr size_t WS_SUBK = 15 * MiB;
constexpr size_t WS_PU = 16 * MiB, WS_PV = 48 * MiB;
constexpr size_t WS_H = 80 * MiB;
constexpr size_t WS_PROJ = 112 * MiB;
constexpr size_t WS_X1 = 112 * MiB;
constexpr size_t WS_H2 = 176 * MiB;
constexpr size_t WS_GLR = 208 * MiB;
constexpr size_t WS_IDX = 209 * MiB, WS_GATE = 217 * MiB;
constexpr int CW_BAR = 4096;

constexpr int RING_BYTES = 131072, LDSCTL_OFF = RING_BYTES, MISC_OFF = LDSCTL_OFF + 320, LDS_BYTES = 147456;

__device__ __forceinline__ unsigned f2bf(float f) { unsigned u = __builtin_bit_cast(unsigned, f); return (u + 0x7fffu + ((u >> 16) & 1u)) >> 16; }
__device__ __forceinline__ unsigned pk2(float lo, float hi) { return f2bf(lo) | (f2bf(hi) << 16); }
__device__ __forceinline__ float bflo(unsigned w) { return __builtin_bit_cast(float, w << 16); }
__device__ __forceinline__ float bfhi(unsigned w) { return __builtin_bit_cast(float, w & 0xffff0000u); }
__device__ __forceinline__ float bf2f(bf16 v) { return __builtin_bit_cast(float, (unsigned)v << 16); }
__device__ __forceinline__ float silu_f(float v) { return v / (1.f + __expf(-v)); }
__device__ __forceinline__ float gelu_f(float v) { return 0.5f * v * (1.f + erff(v * 0.70710678118654752f)); }
__device__ __forceinline__ float logsig_f(float z) { return fminf(z, 0.f) - log1pf(__expf(-fabsf(z))); }
__device__ __forceinline__ float wave_sum(float v) {
#pragma unroll
    for (int o = 1; o < 64; o <<= 1) v += __shfl_xor(v, o);
    return v;
}
#define LDS_WAIT() asm volatile("s_waitcnt lgkmcnt(0)" ::: "memory")


__device__ __forceinline__ unsigned xb_ld(unsigned* p)              { return __hip_atomic_load(p, __ATOMIC_RELAXED, __HIP_MEMORY_SCOPE_AGENT); }
__device__ __forceinline__ unsigned xb_add(unsigned* p, unsigned v) { return __hip_atomic_fetch_add(p, v, __ATOMIC_RELAXED, __HIP_MEMORY_SCOPE_AGENT); }
__device__ __forceinline__ unsigned xb_xcc_id() { return (unsigned)__builtin_amdgcn_s_getreg((3 << 11) | 20) & 0xFu; }
#define XB_SPIN(cond, bar) do { unsigned _sp = 0; while (cond) { __builtin_amdgcn_s_sleep(1); \
    if ((++_sp & 255u) == 0u) { if (xb_ld(&(bar)[XB_TMO])) break; if (_sp > XB_SPIN_CAP) { atomicAdd(&(bar)[XB_TMO], 1u); break; } } } } while (0)

struct XcdBarrier {
    unsigned* bar; unsigned x;
    volatile LAS unsigned* st;
};

__device__ __forceinline__ XcdBarrier xcd_barrier_post(unsigned* bar, volatile LAS unsigned* st) {
    XcdBarrier b; b.bar = bar; b.x = xb_xcc_id(); b.st = st;
    if (threadIdx.x == 0) (void)xb_add(&bar[XB_XCNT(b.x)], 1u);
    return b;
}
__device__ __forceinline__ void xcd_barrier_complete(unsigned* bar, unsigned x, unsigned& nloc, unsigned& nx) {
    const unsigned G = gridDim.x * gridDim.y * gridDim.z;
    unsigned sum, cnt, mine, sp = 0u;
    for (;;) {
        sum = 0u; cnt = 0u; mine = 0u;
#pragma unroll
        for (unsigned j = 0; j < 16; ++j) { const unsigned c = xb_ld(&bar[XB_XCNT(j)]); sum += c; cnt += (c > 0u) ? 1u : 0u; mine = (j == x) ? c : mine; }
        if (sum == G) break;
        __builtin_amdgcn_s_sleep(1);
        if ((++sp & 255u) == 0u) { if (xb_ld(&bar[XB_TMO])) break; if (sp > XB_SPIN_CAP) { atomicAdd(&bar[XB_TMO], 1u); break; } }
    }
    nloc = mine > 0u ? mine : 1u; nx = cnt > 0u ? cnt : 1u;
}

__device__ __forceinline__ void xcd_barrier(const XcdBarrier& b) {
    asm volatile("s_waitcnt vmcnt(0)" ::: "memory");
    __syncthreads();
    if (threadIdx.x == 0) {
        unsigned* bar = b.bar;
        __builtin_amdgcn_s_waitcnt(0);
        unsigned nloc = b.st[0], nx = b.st[1];
        if (nloc == 0u) { xcd_barrier_complete(bar, b.x, nloc, nx); b.st[0] = nloc; b.st[1] = nx; }
        const unsigned old = xb_add(&bar[XB_XSUB(b.x)], 1u);
        const unsigned gen = old / nloc;
        if (old + 1u == (gen + 1u) * nloc) {
            __builtin_amdgcn_fence(__ATOMIC_RELEASE, "agent");
            asm volatile("s_waitcnt vmcnt(0)" ::: "memory");
            const unsigned og = xb_add(&bar[XB_TOP], 1u);
            const unsigned tg = og / nx;
            if (og + 1u == (tg + 1u) * nx) xb_add(&bar[XB_TOPGEN], 1u);
            else XB_SPIN(xb_ld(&bar[XB_TOPGEN]) == tg, bar);
            __builtin_amdgcn_fence(__ATOMIC_ACQUIRE, "agent");
            xb_add(&bar[XB_XGEN(b.x)], 1u);
            asm volatile("s_waitcnt vmcnt(0)" ::: "memory");
        } else {
            XB_SPIN(xb_ld(&bar[XB_XGEN(b.x)]) == gen, bar);
            __builtin_amdgcn_fence(__ATOMIC_ACQUIRE, "agent");
            asm volatile("s_waitcnt vmcnt(0)" ::: "memory");
        }
    }
    __syncthreads();
}


constexpr int ARGT_OFF = LDSCTL_OFF + 1024;
enum ArgIdx { A_X = 0, A_C, A_WMOD, A_BMOD, A_WIN, A_CONVW, A_GATEUP, A_GATEBIAS, A_NORMG, A_WOUT, A_LN1G, A_LN1B, A_WQ, A_SUBK, A_PU, A_PV, A_LN2G, A_LN2B, A_OUT, A_WS, A_COUNT };
struct Ctx { LAS unsigned char* lds; int tid, lane, wave, wg, G, gw, NGW; };
__device__ __forceinline__ unsigned long long ldarg(const Ctx& C, int i) {
    volatile LAS unsigned* p = (volatile LAS unsigned*)(C.lds + ARGT_OFF) + 2 * i;
    const unsigned lo = __builtin_amdgcn_readfirstlane(p[0]), hi = __builtin_amdgcn_readfirstlane(p[1]);
    return ((unsigned long long)hi << 32) | lo;
}
#define ARGF(i) ((const float*)ldarg(C, (i)))
#define ARG_WS ((unsigned char*)ldarg(C, A_WS))
#define ARG_OUT ((float*)ldarg(C, A_OUT))

__device__ __forceinline__ void p0_mod_item(const Ctx& C, int item) {
    LAS float* sc = (LAS float*)C.lds; LAS float* red = sc + BATCH * D;
    float* mod = (float*)(ARG_WS + WS_MOD); const float* c_in = ARGF(A_C); const float* w_mod = ARGF(A_WMOD); const float* b_mod = ARGF(A_BMOD);
    for (int i = C.tid; i < BATCH * D; i += NTHR) sc[i] = silu_f(c_in[i]);
    __syncthreads();
    const int col = C.lane & 31, kp = C.lane >> 5, n0 = item * 32;
    float acc[BATCH];
#pragma unroll
    for (int b = 0; b < BATCH; ++b) acc[b] = 0.f;
    for (int i = 0; i < 64; ++i) {
        const int k = 128 * C.wave + 2 * i + kp; const float wv = w_mod[(size_t)k * (6 * D) + n0 + col];
#pragma unroll
        for (int b = 0; b < BATCH; ++b) acc[b] += sc[b * D + k] * wv;
    }
#pragma unroll
    for (int b = 0; b < BATCH; ++b) acc[b] += __shfl_xor(acc[b], 32);
    if (C.lane < 32) {
#pragma unroll
        for (int b = 0; b < BATCH; ++b) red[(C.wave * 8 + b) * 32 + col] = acc[b];
    }
    __syncthreads();
    if (C.tid < 256) { const int b = C.tid >> 5, cc = C.tid & 31; float s = b_mod[n0 + cc];
#pragma unroll
        for (int w = 0; w < 8; ++w) s += red[(w * 8 + b) * 32 + cc];
        mod[b * (6 * D) + n0 + cc] = s; }
    __syncthreads();
}
__device__ __forceinline__ void p0_transpose_item(const float* W, int ldw, int K, int k0, int n0, bf16* WT, LAS float* scr, int lane) {
#pragma unroll 8
    for (int i = 0; i < 32; ++i) { const int kk = 2 * i + (lane >> 5); scr[kk * 33 + (lane & 31)] = W[(size_t)(k0 + kk) * ldw + n0 + (lane & 31)]; }
    LDS_WAIT(); asm volatile("" ::: "memory");
    const int c = lane & 7;
#pragma unroll
    for (int j = 0; j < 4; ++j) { const int n = (lane >> 3) + 8 * j; const LAS float* s = scr + (8 * c) * 33 + n;
        v4u o; o.x = pk2(s[0 * 33], s[1 * 33]); o.y = pk2(s[2 * 33], s[3 * 33]); o.z = pk2(s[4 * 33], s[5 * 33]); o.w = pk2(s[6 * 33], s[7 * 33]);
        *(v4u*)(WT + (size_t)(n0 + n) * K + k0 + 8 * c) = o; }
    LDS_WAIT(); asm volatile("" ::: "memory");
}
__device__ __forceinline__ void p0_cvt_item(const float* src, bf16* dst, size_t item, int lane) {
#pragma unroll
    for (int r = 0; r < 4; ++r) { const size_t off = item * 2048 + r * 512 + lane * 8; const f32x4 a = *(const f32x4*)(src + off), b = *(const f32x4*)(src + off + 4);
        v4u o; o.x = pk2(a.x, a.y); o.y = pk2(a.z, a.w); o.z = pk2(b.x, b.y); o.w = pk2(b.z, b.w); *(v4u*)(dst + off) = o; }
}
typedef float f32x2 __attribute__((ext_vector_type(2)));
constexpr float PU_SCALE = 32.f, PV_SCALE = 2.f;
__device__ __forceinline__ void p0_cvt8_item(const float* src, unsigned char* dst, size_t item, int lane, float scale) {
#pragma unroll
    for (int r = 0; r < 4; ++r) { const size_t off = item * 4096 + r * 1024 + lane * 16; v4u o;
#pragma unroll
        for (int q = 0; q < 4; ++q) { const f32x4 a = *(const f32x4*)(src + off + 4 * q) * scale; int pk = __builtin_amdgcn_cvt_pk_fp8_f32(a.x, a.y, 0, false); pk = __builtin_amdgcn_cvt_pk_fp8_f32(a.z, a.w, pk, true); o[q] = (unsigned)pk; }
        *(v4u*)(dst + off) = o; }
}
__device__ __forceinline__ void phase0(const Ctx& C) {
    if (C.wg < 192) p0_mod_item(C, C.wg);
    LAS float* scr = (LAS float*)(C.lds + C.wave * 16384);
    unsigned char* ws = ARG_WS; const float* w_in = ARGF(A_WIN); const float* w_out = ARGF(A_WOUT); const float* wq = ARGF(A_WQ); const float* pu = ARGF(A_PU); const float* pv = ARGF(A_PV); const float* subkeys = ARGF(A_SUBK);
    bf16* WIN = (bf16*)(ws + WS_WIN); bf16* WOUT = (bf16*)(ws + WS_WOUT); bf16* WQ = (bf16*)(ws + WS_WQ); bf16* WGLR = (bf16*)(ws + WS_WGLR);
    unsigned char* PU = ws + WS_PU; unsigned char* PV = ws + WS_PV; bf16* SUBK = (bf16*)(ws + WS_SUBK);
    constexpr int I_IN = 16 * 96, I_OUT = 16 * 32, I_Q = 16 * 64, I_U = 4096, I_S = 128;
    constexpr int NITEMS = I_IN + I_OUT + I_Q + 2 * I_U + I_S;
    for (int it = C.gw; it < NITEMS; it += C.NGW) {
        int r = it;
        if (r < I_IN) { p0_transpose_item(w_in, INC, D, 64 * (r / 96), 32 * (r % 96), WIN, scr, C.lane); continue; } r -= I_IN;
        if (r < I_OUT) { p0_transpose_item(w_out, D, D, 64 * (r / 32), 32 * (r % 32), WOUT, scr, C.lane); continue; } r -= I_OUT;
        if (r < I_Q) { p0_transpose_item(wq, NQ, D, 64 * (r / 64), 32 * (r % 64), WQ, scr, C.lane); continue; } r -= I_Q;
        if (r < I_U) { p0_cvt8_item(pu, PU, (size_t)r, C.lane, PU_SCALE); continue; } r -= I_U;
        if (r < I_U) { p0_cvt8_item(pv, PV, (size_t)r, C.lane, PV_SCALE); continue; } r -= I_U;
        p0_cvt_item(subkeys, SUBK, (size_t)r, C.lane);
    }
    for (int i = C.gw * 64 + C.lane; i < RANK * D; i += C.NGW * 64) { const int j = i >> 10, k = i & 1023; WGLR[i] = (bf16)f2bf(w_in[(size_t)k * INC + NPROJ + j]); }
}
__device__ __forceinline__ void phase0b(const Ctx& C) {
    unsigned char* ws = ARG_WS; const float* x = ARGF(A_X);
    const float* mod = (const float*)(ws + WS_MOD); bf16* H = (bf16*)(ws + WS_H);
    for (int m = C.gw; m < M; m += C.NGW) {
        const int b = m / SEQ; const f32x4* sh = (const f32x4*)(mod + b * 6 * D) + C.lane; const f32x4* sc = (const f32x4*)(mod + b * 6 * D + D) + C.lane;
        const f32x4* xr = (const f32x4*)(x + (size_t)m * D) + C.lane;
        unsigned long long* o8 = (unsigned long long*)(H + (size_t)m * D) + C.lane;
#pragma unroll
        for (int j = 0; j < 4; ++j) { const f32x4 v = xr[64 * j] * (sc[64 * j] + 1.0f) + sh[64 * j]; o8[64 * j] = (unsigned long long)pk2(v.x, v.y) | ((unsigned long long)pk2(v.z, v.w) << 32); }
    }
}
struct EpiF32 {
    static constexpr bool PERM = false, AFTER_DRAIN = false;
    float* O; int ldc;
    __device__ __forceinline__ void operator()(const pg8::f32x4 (&acc)[2][2][4][2], const pg8::Unit& u, int wr, int wc, int fr, int fq) const {
        const int col0 = u.pn * 256 + wc * 32 + 4 * fq;
#pragma unroll
        for (int ai = 0; ai < 2; ++ai)
#pragma unroll
            for (int m = 0; m < 4; ++m) { float* rowp = O + (size_t)(u.pm * 256 + ai * 128 + wr * 64 + m * 16 + fr) * ldc + col0;
#pragma unroll
                for (int bj = 0; bj < 2; ++bj)
#pragma unroll
                    for (int n = 0; n < 2; ++n) *(pg8::f32x4*)(rowp + bj * 128 + n * 16) = acc[ai][bj][m][n]; }
    }
};
__device__ __forceinline__ void glr_simple(const Ctx& C) {
    unsigned char* ws = ARG_WS;
    const bf16* H = (const bf16*)(ws + WS_H); const bf16* WGLR = (const bf16*)(ws + WS_WGLR); float* GLR = (float*)(ws + WS_GLR);
    for (int i = C.gw * 64 + C.lane; i < M * RANK; i += C.NGW * 64) {
        const int m = i >> 4, j = i & 15; const v4u* hr = (const v4u*)(H + (size_t)m * D); const v4u* wr = (const v4u*)(WGLR + (size_t)j * D);
        float acc = 0.f;
        for (int kc = 0; kc < 128; ++kc) { const v4u a = hr[kc], w = wr[kc];
            acc += bflo(a.x) * bflo(w.x) + bfhi(a.x) * bfhi(w.x) + bflo(a.y) * bflo(w.y) + bfhi(a.y) * bfhi(w.y) + bflo(a.z) * bflo(w.z) + bfhi(a.z) * bfhi(w.z) + bflo(a.w) * bflo(w.w) + bfhi(a.w) * bfhi(w.w); }
        GLR[i] = acc;
    }
}
__device__ __forceinline__ void conv_phase(const Ctx& C) {
    unsigned char* ws = ARG_WS; const float* conv_w = ARGF(A_CONVW);
    const bf16* PROJ = (const bf16*)(ws + WS_PROJ); bf16* YMIX = (bf16*)(ws + WS_H);
    for (int i = C.gw * 64 + C.lane; i < M * 64; i += C.NGW * 64) {
        const int m = i >> 6, c = (i & 63) * 8, s = m % SEQ;
        float z[8];
#pragma unroll
        for (int k = 0; k < 8; ++k) z[k] = 0.f;
#pragma unroll
        for (int j = 0; j < 3; ++j) { const int sp = s - 2 + j;
            if (sp >= 0) { const bf16* row = PROJ + (size_t)(m - 2 + j) * NPROJ; const v4u cc = *(const v4u*)(row + CONVW + c), ch = *(const v4u*)(row + 2 * CONVW + c);
                const f32x4 w0 = *(const f32x4*)(conv_w + j * CONVW + c), w1 = *(const f32x4*)(conv_w + j * CONVW + c + 4);
                z[0] += w0.x * bflo(cc.x) * bflo(ch.x); z[1] += w0.y * bfhi(cc.x) * bfhi(ch.x); z[2] += w0.z * bflo(cc.y) * bflo(ch.y); z[3] += w0.w * bfhi(cc.y) * bfhi(ch.y);
                z[4] += w1.x * bflo(cc.z) * bflo(ch.z); z[5] += w1.y * bfhi(cc.z) * bfhi(ch.z); z[6] += w1.z * bflo(cc.w) * bflo(ch.w); z[7] += w1.w * bfhi(cc.w) * bfhi(ch.w); } }
        const v4u cb = *(const v4u*)(PROJ + (size_t)m * NPROJ + c);
        v4u o; o.x = pk2(bflo(cb.x) * z[0], bfhi(cb.x) * z[1]); o.y = pk2(bflo(cb.y) * z[2], bfhi(cb.y) * z[3]); o.z = pk2(bflo(cb.z) * z[4], bfhi(cb.z) * z[5]); o.w = pk2(bflo(cb.w) * z[6], bfhi(cb.w) * z[7]);
        *(v4u*)(YMIX + (size_t)m * D + c) = o;
    }
}
constexpr size_t GO_KV = 0, GO_SPREV = 34 * MiB, GO_DECAY = 52 * MiB;
constexpr int G_GLR = 0, G_T = 4096, G_K = 8192, G_Q = 16384, G_V = 24576, G_S = 43008, G_QE = 61440, G_KE = 70656, G_AT = 79872, G_SS = 90112;
constexpr int VS_B = 272, QS_B = 144;
typedef short v4i16_t __attribute__((ext_vector_type(4)));
__device__ __forceinline__ bf16x8 tr_frag(const LAS unsigned char* tile, int stride, int ks, int c, int lane) {
    const int g = lane >> 4, q = (lane & 15) >> 2, pp = lane & 3;
    const LAS unsigned char* a = tile + (32 * ks + 8 * g + q) * stride + (16 * c + 4 * pp) * 2;
    const v4i16_t lo = __builtin_amdgcn_ds_read_tr16_b64_v4i16((LAS v4i16_t*)a);
    const v4i16_t hi = __builtin_amdgcn_ds_read_tr16_b64_v4i16((LAS v4i16_t*)(a + 4 * stride));
    bf16x8 r; r[0] = lo[0]; r[1] = lo[1]; r[2] = lo[2]; r[3] = lo[3]; r[4] = hi[0]; r[5] = hi[1]; r[6] = hi[2]; r[7] = hi[3]; return r;
}
__device__ __forceinline__ bf16x8 row_frag(const LAS unsigned char* tile, int stride, int ks, int c, int lane) {
    return *(const LAS bf16x8*)(tile + (16 * c + (lane & 15)) * stride + (32 * ks + 8 * (lane >> 4)) * 2);
}
template <bool PASS_C>
__device__ __forceinline__ void gla_stage_prefix(const Ctx& C, const bf16* PROJ, const float* GLR, const bf16* SPREV, const float* gate_up, const float* gate_bias, int m0, int hd, int kvidx, float (&bc)[8], float& blast) {
    const int tid = C.tid;
    __syncthreads();
    if (tid < 256) *(LAS v4u*)(C.lds + G_GLR + tid * 16) = *(const v4u*)(GLR + (size_t)m0 * RANK + tid * 4);
    { const int row = tid >> 3, ch = tid & 7; const bf16* src = PROJ + (size_t)(m0 + row) * NPROJ + hd * DK + ch * 8;
      *(LAS v4u*)(C.lds + G_K + row * 128 + ch * 16) = *(const v4u*)(src + 1792);
      if (PASS_C) *(LAS v4u*)(C.lds + G_Q + row * 128 + ch * 16) = *(const v4u*)(src + 1536); }
#pragma unroll
    for (int i = 0; i < 2; ++i) { const int idx = tid + i * NTHR, row = idx >> 4, ch = idx & 15;
        *(LAS v4u*)(C.lds + G_V + row * VS_B + ch * 16) = *(const v4u*)(PROJ + (size_t)(m0 + row) * NPROJ + 2048 + hd * DV + ch * 8);
        if (PASS_C) *(LAS v4u*)(C.lds + G_S + row * VS_B + ch * 16) = *(const v4u*)(SPREV + (size_t)kvidx * (DK * DV) + row * DV + ch * 8); }
    const int d = tid & 63, rb = tid >> 6;
    float gu[RANK];
#pragma unroll
    for (int j = 0; j < RANK; ++j) gu[j] = gate_up[j * GK + hd * DK + d];
    const float bias = gate_bias[hd * DK + d];
    __syncthreads();
    float run = 0.f;
#pragma unroll
    for (int i = 0; i < 8; ++i) { const LAS float* gr = (const LAS float*)(C.lds + G_GLR) + (rb * 8 + i) * RANK; float z = bias;
#pragma unroll
        for (int j = 0; j < RANK; ++j) z += gr[j] * gu[j];
        run += logsig_f(z) * (1.f / 16.f); bc[i] = run; }
    ((LAS float*)(C.lds + G_T))[rb * 64 + d] = run;
    __syncthreads();
    float off = 0.f; blast = 0.f;
#pragma unroll
    for (int r2 = 0; r2 < 8; ++r2) { const float tv = ((const LAS float*)(C.lds + G_T))[r2 * 64 + d]; blast += tv; if (r2 < rb) off += tv; }
#pragma unroll
    for (int i = 0; i < 8; ++i) bc[i] += off;
}
__device__ __forceinline__ void gla_pass_a(const Ctx& C) {
    unsigned char* ws = ARG_WS; unsigned char* ob = (unsigned char*)ARG_OUT; const float* gate_up = ARGF(A_GATEUP); const float* gate_bias = ARGF(A_GATEBIAS);
    const bf16* PROJ = (const bf16*)(ws + WS_PROJ); const float* GLR = (const float*)(ws + WS_GLR);
    float* KV = (float*)(ob + GO_KV); float* DECAY = (float*)(ob + GO_DECAY);
    const int lane = C.lane, w = C.wave;
    for (int item = C.wg; item < BATCH * 32 * NH; item += C.G) {
        const int hd = item & 3, bn = item >> 2, b = bn >> 5, n = bn & 31, m0 = bn * 64, kvidx = (b * NH + hd) * 32 + n;
        float bc[8], blast;
        gla_stage_prefix<false>(C, PROJ, GLR, nullptr, gate_up, gate_bias, m0, hd, kvidx, bc, blast);
        const int d = C.tid & 63, rb = C.tid >> 6;
#pragma unroll
        for (int i = 0; i < 8; ++i) { const int r = rb * 8 + i; const float kk = bf2f(*(const LAS bf16*)(C.lds + G_K + r * 128 + d * 2));
            *(LAS bf16*)(C.lds + G_QE + r * QS_B + d * 2) = (bf16)f2bf(kk * __expf(blast - bc[i])); }
        if (rb == 0) DECAY[(size_t)kvidx * DK + d] = __expf(blast);
        __syncthreads();
        const int dt = w & 3, e0 = (w >> 2) * 4;
        f32x4 acc[4];
#pragma unroll
        for (int j = 0; j < 4; ++j) acc[j] = (f32x4){0.f, 0.f, 0.f, 0.f};
#pragma unroll
        for (int ks = 0; ks < 2; ++ks) { const bf16x8 a = tr_frag(C.lds + G_QE, QS_B, ks, dt, lane);
#pragma unroll
            for (int j = 0; j < 4; ++j) { const bf16x8 bb = tr_frag(C.lds + G_V, VS_B, ks, e0 + j, lane); acc[j] = __builtin_amdgcn_mfma_f32_16x16x32_bf16(a, bb, acc[j], 0, 0, 0); } }
        float* kvp = KV + (size_t)kvidx * (DK * DV);
#pragma unroll
        for (int j = 0; j < 4; ++j)
#pragma unroll
            for (int r = 0; r < 4; ++r) kvp[(16 * dt + 4 * (lane >> 4) + r) * DV + 16 * (e0 + j) + (lane & 15)] = acc[j][r];
    }
    __syncthreads();
}
__device__ __forceinline__ void gla_scan(const Ctx& C) {
    unsigned char* ob = (unsigned char*)ARG_OUT;
    const float* KV = (const float*)(ob + GO_KV); const float* DECAY = (const float*)(ob + GO_DECAY); unsigned* SP = (unsigned*)(ob + GO_SPREV);
    for (int gt = C.gw * 64 + C.lane; gt < BATCH * NH * DK * (DV / 2); gt += C.NGW * 64) {
        const int bh = gt >> 12, d = (gt >> 6) & 63, e2 = gt & 63;
        float s0 = 0.f, s1 = 0.f;
#pragma unroll 8
        for (int n = 0; n < 32; ++n) { const size_t base = (size_t)(bh * 32 + n) * (DK * DV) + d * DV + 2 * e2;
            const float2 kv = *(const float2*)(KV + base); const float dec = DECAY[(size_t)(bh * 32 + n) * DK + d];
            SP[base >> 1] = pk2(s0, s1); s0 = dec * s0 + kv.x; s1 = dec * s1 + kv.y; }
    }
}
__device__ __forceinline__ void gla_pass_c(const Ctx& C) {
    unsigned char* ws = ARG_WS; unsigned char* ob = (unsigned char*)ARG_OUT; const float* gate_up = ARGF(A_GATEUP); const float* gate_bias = ARGF(A_GATEBIAS); const float* norm_g = ARGF(A_NORMG);
    const bf16* PROJ = (const bf16*)(ws + WS_PROJ); const float* GLR = (const float*)(ws + WS_GLR); bf16* YMIX = (bf16*)(ws + WS_H);
    const bf16* SPREV = (const bf16*)(ob + GO_SPREV);
    const int lane = C.lane, w = C.wave, fr = lane & 15, fq = lane >> 4;
    for (int item = C.wg; item < BATCH * 32 * NH; item += C.G) {
        const int hd = item & 3, bn = item >> 2, b = bn >> 5, n = bn & 31, m0 = bn * 64, kvidx = (b * NH + hd) * 32 + n;
        float bc[8], blast;
        gla_stage_prefix<true>(C, PROJ, GLR, SPREV, gate_up, gate_bias, m0, hd, kvidx, bc, blast);
        const int d = C.tid & 63, rb = C.tid >> 6;
#pragma unroll
        for (int i = 0; i < 8; ++i) { const int r = rb * 8 + i; const float kk = bf2f(*(const LAS bf16*)(C.lds + G_K + r * 128 + d * 2)), qq = bf2f(*(const LAS bf16*)(C.lds + G_Q + r * 128 + d * 2));
            *(LAS bf16*)(C.lds + G_QE + r * QS_B + d * 2) = (bf16)f2bf(qq * 0.125f * __expf(bc[i]));
            *(LAS bf16*)(C.lds + G_KE + r * QS_B + d * 2) = (bf16)f2bf(kk * __expf(-bc[i])); }
        __syncthreads();
        {
            const int ct = w >> 1, mt0 = (w & 1) * 2;
            f32x4 at[2] = {(f32x4){0.f, 0.f, 0.f, 0.f}, (f32x4){0.f, 0.f, 0.f, 0.f}};
#pragma unroll
            for (int ks = 0; ks < 2; ++ks) { const bf16x8 a = row_frag(C.lds + G_QE, QS_B, ks, ct, lane);
#pragma unroll
                for (int j = 0; j < 2; ++j) { const bf16x8 bb = row_frag(C.lds + G_KE, QS_B, ks, mt0 + j, lane); at[j] = __builtin_amdgcn_mfma_f32_16x16x32_bf16(a, bb, at[j], 0, 0, 0); } }
#pragma unroll
            for (int j = 0; j < 2; ++j)
#pragma unroll
                for (int r = 0; r < 4; ++r) { const int cc = 16 * ct + 4 * fq + r, mm = 16 * (mt0 + j) + fr; *(LAS bf16*)(C.lds + G_AT + cc * QS_B + mm * 2) = (bf16)f2bf(mm <= cc ? at[j][r] : 0.f); }
        }
        __syncthreads();
        const int ct = w & 3, e0 = (w >> 2) * 4;
        f32x4 acc[4];
#pragma unroll
        for (int j = 0; j < 4; ++j) acc[j] = (f32x4){0.f, 0.f, 0.f, 0.f};
#pragma unroll
        for (int ks = 0; ks < 2; ++ks) { const bf16x8 a = row_frag(C.lds + G_AT, QS_B, ks, ct, lane);
#pragma unroll
            for (int j = 0; j < 4; ++j) { const bf16x8 bb = tr_frag(C.lds + G_V, VS_B, ks, e0 + j, lane); acc[j] = __builtin_amdgcn_mfma_f32_16x16x32_bf16(a, bb, acc[j], 0, 0, 0); } }
#pragma unroll
        for (int ks = 0; ks < 2; ++ks) { const bf16x8 a = row_frag(C.lds + G_QE, QS_B, ks, ct, lane);
#pragma unroll
            for (int j = 0; j < 4; ++j) { const bf16x8 bb = tr_frag(C.lds + G_S, VS_B, ks, e0 + j, lane); acc[j] = __builtin_amdgcn_mfma_f32_16x16x32_bf16(a, bb, acc[j], 0, 0, 0); } }
        float ss[4];
#pragma unroll
        for (int r = 0; r < 4; ++r) { float s = 0.f;
#pragma unroll
            for (int j = 0; j < 4; ++j) s += acc[j][r] * acc[j][r];
            s += __shfl_xor(s, 1); s += __shfl_xor(s, 2); s += __shfl_xor(s, 4); s += __shfl_xor(s, 8); ss[r] = s; }
        if (fr == 0) {
#pragma unroll
            for (int r = 0; r < 4; ++r) ((LAS float*)(C.lds + G_SS))[(16 * ct + 4 * fq + r) * 2 + (w >> 2)] = ss[r]; }
        __syncthreads();
#pragma unroll
        for (int r = 0; r < 4; ++r) { const int cc = 16 * ct + 4 * fq + r; const LAS float* sp = (const LAS float*)(C.lds + G_SS) + cc * 2;
            const float rs = rsqrtf((sp[0] + sp[1]) * (1.f / DV) + RMS_EPS); const size_t m = (size_t)(m0 + cc);
#pragma unroll
            for (int j = 0; j < 4; ++j) { const int e = 16 * (e0 + j) + fr; const float rr = bf2f(PROJ[m * NPROJ + 2560 + hd * DV + e]);
                YMIX[m * D + CONVW + hd * DV + e] = (bf16)f2bf(acc[j][r] * rs * norm_g[hd * DV + e] * silu_f(rr)); } }
    }
    __syncthreads();
}
__device__ __forceinline__ void ln1_phase(const Ctx& C) {
    unsigned char* ws = ARG_WS; const float* x = ARGF(A_X); const float* ln1_g = ARGF(A_LN1G); const float* ln1_b = ARGF(A_LN1B);
    const float* mod = (const float*)(ws + WS_MOD); const float* Y = ARG_OUT; float* X1 = (float*)(ws + WS_X1); bf16* H2 = (bf16*)(ws + WS_H2);
    for (int m = C.gw; m < M; m += C.NGW) {
        const int b = m / SEQ; const float* mrow = mod + b * 6 * D;
        const f32x4* g1 = (const f32x4*)(mrow + 2 * D) + C.lane; const f32x4* sh2 = (const f32x4*)(mrow + 3 * D) + C.lane; const f32x4* sc2 = (const f32x4*)(mrow + 4 * D) + C.lane;
        const f32x4* xr = (const f32x4*)(x + (size_t)m * D) + C.lane; const f32x4* yr = (const f32x4*)(Y + (size_t)m * D) + C.lane;
        f32x4 v[4]; float s = 0.f;
#pragma unroll
        for (int j = 0; j < 4; ++j) { v[j] = xr[64 * j] * ALPHA + (g1[64 * j] + 1.0f) * yr[64 * j]; s += (v[j].x + v[j].y) + (v[j].z + v[j].w); }
        const float mean = wave_sum(s) * (1.f / D); float q = 0.f;
#pragma unroll
        for (int j = 0; j < 4; ++j) { v[j] = v[j] - mean; q += (v[j].x * v[j].x + v[j].y * v[j].y) + (v[j].z * v[j].z + v[j].w * v[j].w); }
        const float rstd = rsqrtf(wave_sum(q) * (1.f / D) + LN_EPS);
        f32x4* xo = (f32x4*)(X1 + (size_t)m * D) + C.lane; unsigned long long* ho = (unsigned long long*)(H2 + (size_t)m * D) + C.lane;
#pragma unroll
        for (int j = 0; j < 4; ++j) { const f32x4 x1 = v[j] * rstd * ((const f32x4*)ln1_g)[C.lane + 64 * j] + ((const f32x4*)ln1_b)[C.lane + 64 * j]; xo[64 * j] = x1;
            const f32x4 h2 = x1 * (sc2[64 * j] + 1.0f) + sh2[64 * j]; ho[64 * j] = (unsigned long long)pk2(h2.x, h2.y) | ((unsigned long long)pk2(h2.z, h2.w) << 32); }
    }
}
__device__ __forceinline__ int fkey(float f) { const int b = __builtin_bit_cast(int, f); return b ^ ((b >> 31) & 0x7fffffff); }
__device__ __forceinline__ float kfloat(int k) { const int b = k ^ ((k >> 31) & 0x7fffffff); return __builtin_bit_cast(float, b); }
template <int N> __device__ __forceinline__ void sort16_groups_desc(int (&v)[N]) {
#pragma unroll
    for (int ks = 1; ks <= 4; ++ks)
#pragma unroll
        for (int js = ks - 1; js >= 0; --js)
#pragma unroll
            for (int i = 0; i < N; ++i) { const int k = 1 << ks, j = 1 << js, l = i ^ j;
                if (l > i) { const bool desc = ((i & 15 & k) == 0); const int mx = max(v[i], v[l]), mn = min(v[i], v[l]); v[i] = desc ? mx : mn; v[l] = desc ? mn : mx; } }
}
template <int OA, int OB, int N> __device__ __forceinline__ void merge_top16(int (&v)[N]) {
#pragma unroll
    for (int i = 0; i < 16; ++i) v[OA + i] = max(v[OA + i], v[OB + 15 - i]);
#pragma unroll
    for (int js = 3; js >= 0; --js)
#pragma unroll
        for (int i = 0; i < 16; ++i) { const int j = 1 << js, l = i ^ j; if (l > i) { const int mx = max(v[OA + i], v[OA + l]), mn = min(v[OA + i], v[OA + l]); v[OA + i] = mx; v[OA + l] = mn; } }
}
__device__ __forceinline__ void top16_of_64(int (&v)[64]) { sort16_groups_desc<64>(v); merge_top16<0, 16, 64>(v); merge_top16<32, 48, 64>(v); merge_top16<0, 32, 64>(v); }
constexpr int cand_n(int a) { return a == 0 ? 16 : 16 / (a + 1); }
constexpr int cand_off(int a) { int s = 0; for (int i = 0; i < a; ++i) s += cand_n(i); return s; }
static_assert(cand_off(16) == 50, "staircase candidate count");

__device__ __forceinline__ void route_item(const bf16* Q, const bf16* SUBK, int* IDX, float* GATE, int tg, int h, LAS unsigned char* slot, int lane) {
    const int col = lane & 31, hi = lane >> 5, t = tg * 32 + col;
    LAS int* tl = (LAS int*)slot + lane;
#pragma unroll 1
    for (int p = 0; p < 2; ++p) {
        f32x16 acc[4];
#pragma unroll
        for (int kt = 0; kt < 4; ++kt)
#pragma unroll
            for (int r = 0; r < 16; ++r) acc[kt][r] = 0.f;
        const bf16* qrow = Q + (size_t)t * NQ + h * 256 + p * 128 + 8 * hi;
        const bf16* kb = SUBK + ((size_t)(h * 2 + p) * NKEYS + col) * 128 + 8 * hi;
#pragma unroll
        for (int ks = 0; ks < 8; ++ks) { const bf16x8 bq = *(const bf16x8*)(qrow + ks * 16);
#pragma unroll
            for (int kt = 0; kt < 4; ++kt) { const bf16x8 ak = *(const bf16x8*)(kb + (size_t)kt * 32 * 128 + ks * 16); acc[kt] = __builtin_amdgcn_mfma_f32_32x32x16_bf16(ak, bq, acc[kt], 0, 0, 0); } }
        int v[64];
#pragma unroll
        for (int kt = 0; kt < 4; ++kt)
#pragma unroll
            for (int r = 0; r < 16; ++r) { const int n = kt * 32 + 8 * (r >> 2) + (r & 3) + 4 * hi; v[kt * 16 + r] = (fkey(acc[kt][r]) & ~0x7F) | n; }
        top16_of_64(v);
#pragma unroll
        for (int i = 0; i < 16; ++i) v[16 + i] = __shfl_xor(v[i], 32);
        merge_top16<0, 16, 64>(v);
#pragma unroll
        for (int i = 0; i < 16; ++i) tl[(p * 16 + i) * 64] = v[i];
    }
    int c[64];
    {
        float s1[16], s2[16];
#pragma unroll
        for (int i = 0; i < 16; ++i) { s1[i] = kfloat(tl[i * 64] & ~0x7F); s2[i] = kfloat(tl[(16 + i) * 64] & ~0x7F); }
#pragma unroll
        for (int a = 0; a < 16; ++a)
#pragma unroll
            for (int b = 0; b < 16; ++b) if (b < cand_n(a)) c[cand_off(a) + b] = (fkey(s1[a] + s2[b]) & ~0xFF) | (a * 16 + b);
    }
#pragma unroll
    for (int i = 50; i < 64; ++i) c[i] = (int)0x80000000;
    top16_of_64(c);
    const float mx = kfloat(c[0] & ~0xFF);
    float ev[16]; float sum = 0.f; int id[16];
#pragma unroll
    for (int i = 0; i < 16; ++i) { ev[i] = __expf(kfloat(c[i] & ~0xFF) - mx); sum += ev[i]; const int ab = c[i] & 0xFF; id[i] = (tl[(ab >> 4) * 64] & 0x7F) * NKEYS + (tl[(16 + (ab & 15)) * 64] & 0x7F); }
    const float inv = 1.f / sum;
    if (hi == 0) { int* dst = IDX + ((size_t)t * PH + h) * TOPK;
#pragma unroll
        for (int q4 = 0; q4 < 4; ++q4) { v4u o; o.x = (unsigned)id[4 * q4]; o.y = (unsigned)id[4 * q4 + 1]; o.z = (unsigned)id[4 * q4 + 2]; o.w = (unsigned)id[4 * q4 + 3]; *(v4u*)(dst + 4 * q4) = o; }
    } else { float* dst = GATE + ((size_t)t * PH + h) * TOPK;
#pragma unroll
        for (int q4 = 0; q4 < 4; ++q4) { f32x4 o; o.x = ev[4 * q4] * inv; o.y = ev[4 * q4 + 1] * inv; o.z = ev[4 * q4 + 2] * inv; o.w = ev[4 * q4 + 3] * inv; *(f32x4*)(dst + 4 * q4) = o; }
    }
}
__device__ __forceinline__ void route_phase(const Ctx& C) {
    unsigned char* ws = ARG_WS;
    const bf16* Q = (const bf16*)ARG_OUT; const bf16* SUBK = (const bf16*)(ws + WS_SUBK); int* IDX = (int*)(ws + WS_IDX); float* GATE = (float*)(ws + WS_GATE);
    for (int item = C.gw; item < (M / 32) * PH; item += C.NGW) route_item(Q, SUBK, IDX, GATE, item >> 3, item & 7, C.lds + C.wave * 8192, C.lane);
}
__device__ __forceinline__ void unpack8(const v4u p, float* f) { f[0] = bflo(p.x); f[1] = bfhi(p.x); f[2] = bflo(p.y); f[3] = bfhi(p.y); f[4] = bflo(p.z); f[5] = bfhi(p.z); f[6] = bflo(p.w); f[7] = bfhi(p.w); }
__device__ __forceinline__ void unpack_fp8x16(const v4u p, float* f) {
#pragma unroll
    for (int q = 0; q < 4; ++q) { const f32x2 lo = __builtin_amdgcn_cvt_pk_f32_fp8((int)p[q], false), hi = __builtin_amdgcn_cvt_pk_f32_fp8((int)p[q], true); f[4 * q] = lo.x; f[4 * q + 1] = lo.y; f[4 * q + 2] = hi.x; f[4 * q + 3] = hi.y; }
}
typedef __bf16 bf16v2 __attribute__((ext_vector_type(2)));
__device__ __forceinline__ float gelu_as(float v) {
    const float av = fabsf(v), dd = av * 0.2316418882f + 1.0f, t = __builtin_amdgcn_rcpf(dd);
    float q = t * 0.5307027145f + (-0.7265760135f); q = q * t + 0.7107068705f; q = q * t + (-0.142248368f); q = q * t + 0.127414796f; q = q * t;
    const float e = __builtin_amdgcn_exp2f((v * v) * (-0.72134752044f)), m = v * (q * e), r = v - m;
    return v < 0.f ? m : r;
}
__device__ __forceinline__ float wave_sum_dpp63(float v) {
    v += __builtin_bit_cast(float, __builtin_amdgcn_update_dpp(0, __builtin_bit_cast(int, v), 0xB1, 0xf, 0xf, true));
    v += __builtin_bit_cast(float, __builtin_amdgcn_update_dpp(0, __builtin_bit_cast(int, v), 0x4E, 0xf, 0xf, true));
    v += __builtin_bit_cast(float, __builtin_amdgcn_update_dpp(0, __builtin_bit_cast(int, v), 0x141, 0xf, 0xf, true));
    v += __builtin_bit_cast(float, __builtin_amdgcn_update_dpp(0, __builtin_bit_cast(int, v), 0x140, 0xf, 0xf, true));
    v += __builtin_bit_cast(float, __builtin_amdgcn_update_dpp(0, __builtin_bit_cast(int, v), 0x142, 0xa, 0xf, true));
    v += __builtin_bit_cast(float, __builtin_amdgcn_update_dpp(0, __builtin_bit_cast(int, v), 0x143, 0xc, 0xf, true));
    return v;
}
#define LDU(T, ubase, off) (*(const GAS T*)((const GAS char*)(ubase) + (off)))
template <int RESYNC>
__device__ __forceinline__ void peer_phase(const Ctx& C, const XcdBarrier& bar) {
    unsigned char* ws = ARG_WS; float* out = ARG_OUT; const float* ln2_g = ARGF(A_LN2G); const float* ln2_b = ARGF(A_LN2B);
    const float* mod = (const float*)(ws + WS_MOD); const bf16* H2 = (const bf16*)(ws + WS_H2); const unsigned char* PU = ws + WS_PU; const unsigned char* PV = ws + WS_PV;
    const int* IDX = (const int*)(ws + WS_IDX); const float* GATE = (const float*)(ws + WS_GATE); const float* X1 = (const float*)(ws + WS_X1);
    const int lane = C.lane; unsigned l4 = (unsigned)lane * 4u, l16 = (unsigned)lane * 16u, l32 = (unsigned)lane * 32u, l64 = (unsigned)lane * 64u;
#define OPAQUE_OFFS() asm volatile("" : "+v"(l4), "+v"(l16), "+v"(l32), "+v"(l64))
    LAS int* sl = (LAS int*)(C.lds + LDSCTL_OFF + 4096 + C.wave * 1024); LAS float* slf = (LAS float*)sl + 128;
    LAS unsigned char* ring = C.lds + C.wave * 16384;
    constexpr int TOK = 4;
    static_assert(M == 2048 * 2 * TOK, "two rounds: 2048 waves x 4 tokens");
#pragma unroll 1
    for (int hb = 0; hb < 2; ++hb) {
    const int tbase = (hb * C.NGW + C.gw) * TOK;
    OPAQUE_OFFS();
    int seA[TOK], seB[TOK]; float sgA[TOK], sgB[TOK];
    {
        unsigned hp[TOK][8];
#pragma unroll
        for (int s = 0; s < TOK; ++s) {
            const int t = tbase + s;
            const int id0 = LDU(int, IDX + (size_t)t * 128, l4), id1 = LDU(int, IDX + (size_t)t * 128 + 64, l4);
            const float g0 = LDU(float, GATE + (size_t)t * 128, l4), g1 = LDU(float, GATE + (size_t)t * 128 + 64, l4);
            const int key0 = id0 * 128 + lane, key1 = id1 * 128 + 64 + lane;
            int rk0 = 0, rk1 = 0;
#pragma unroll 8
            for (int i = 0; i < 64; ++i) { const int ka = __builtin_amdgcn_readlane(key0, i), kb = __builtin_amdgcn_readlane(key1, i);
                rk0 += (ka < key0 ? 1 : 0) + (kb < key0 ? 1 : 0); rk1 += (ka < key1 ? 1 : 0) + (kb < key1 ? 1 : 0); }
            sl[rk0] = id0; sl[rk1] = id1; slf[rk0] = g0; slf[rk1] = g1;
            seA[s] = sl[2 * lane]; seB[s] = sl[2 * lane + 1]; sgA[s] = slf[2 * lane]; sgB[s] = slf[2 * lane + 1];
            const v4u p0 = LDU(v4u, H2 + (size_t)t * D, l32), p1 = LDU(v4u, H2 + (size_t)t * D + 8, l32);
            hp[s][0] = p0.x; hp[s][1] = p0.y; hp[s][2] = p0.z; hp[s][3] = p0.w; hp[s][4] = p1.x; hp[s][5] = p1.y; hp[s][6] = p1.z; hp[s][7] = p1.w;
        }
        OPAQUE_OFFS();
        float geA[TOK], geB[TOK];
#pragma unroll
        for (int s = 0; s < TOK; ++s) { geA[s] = 0.f; geB[s] = 0.f; }
#define ROW_DMA(table, e, slot) __builtin_amdgcn_global_load_lds((const GAS unsigned*)((const GAS char*)(table) + ((size_t)(e) << 10) + l16), (LAS unsigned*)(ring + (slot) * 1024), 16, 0, 0)
#define ROW_READ(buf, slot4) { _Pragma("unroll") for (int s = 0; s < TOK; ++s) rr[buf][s] = *(const LAS v4u*)(ring + ((slot4) * TOK + s) * 1024 + l16); }
#define PU_LOAD(st, SE, ln) { _Pragma("unroll") for (int s = 0; s < TOK; ++s) { const int e_ = __builtin_amdgcn_readlane(SE[s], (ln)); ROW_DMA(PU, e_, (st) * TOK + s); } }
#define PU_DOTS(buf, GE, ln) { const bool me_ = (lane == (ln));                                                                                                \
            _Pragma("unroll") for (int s = 0; s < TOK; ++s) { float d_ = 0.f; const v4u w_ = rr[buf][s];                                                       \
                _Pragma("unroll") for (int q = 0; q < 4; ++q) {                                                                                                \
                    d_ = __builtin_amdgcn_fdot2_f32_bf16(__builtin_amdgcn_cvt_scalef32_pk_bf16_fp8((int)w_[q], 1.f / PU_SCALE, false), __builtin_bit_cast(bf16v2, hp[s][2 * q]), d_, false);       \
                    d_ = __builtin_amdgcn_fdot2_f32_bf16(__builtin_amdgcn_cvt_scalef32_pk_bf16_fp8((int)w_[q], 1.f / PU_SCALE, true), __builtin_bit_cast(bf16v2, hp[s][2 * q + 1]), d_, false); } \
                const float tot_ = __builtin_bit_cast(float, __builtin_amdgcn_readlane(__builtin_bit_cast(int, wave_sum_dpp63(d_)), 63)); GE[s] = me_ ? tot_ : GE[s]; } }
        v4u rr[2][TOK];
#ifndef PROBE_UDUP
#define PROBE_UDUP 0
#endif
#pragma unroll 1
        for (int urep_ = 0; urep_ <= PROBE_UDUP; ++urep_) {
        asm volatile("s_waitcnt vmcnt(0)" ::: "memory");
        PU_LOAD(0, seA, 0) PU_LOAD(1, seB, 0) PU_LOAD(2, seA, 1)
        asm volatile("s_waitcnt vmcnt(8)" ::: "memory");
        ROW_READ(0, 0)
#pragma unroll 1
        for (int k = 0; k < 128; k += 4) {
            const int kh = k >> 1;
#pragma unroll
            for (int j = 0; j < 4; ++j) {
                { const int lj = kh + ((j + 3) >> 1), ln = lj < 63 ? lj : 63;
                  if ((j + 3) & 1) PU_LOAD((j + 3) % 4, seB, ln) else PU_LOAD((j + 3) % 4, seA, ln) }
                asm volatile("s_waitcnt vmcnt(8)" ::: "memory");
                ROW_READ((j + 1) & 1, (j + 1) % 4)
                if (j & 1) PU_DOTS(j & 1, geB, kh + (j >> 1)) else PU_DOTS(j & 1, geA, kh + (j >> 1))
            }
        }
        asm volatile("s_waitcnt vmcnt(0)" ::: "memory");
        }
#undef PU_LOAD
#undef PU_DOTS
        asm volatile("" ::: "memory");
#pragma unroll
        for (int s = 0; s < TOK; ++s) { geA[s] = gelu_as(geA[s]); geB[s] = gelu_as(geB[s]); }
#pragma unroll
        for (int s = 0; s < TOK; ++s) { sgA[s] *= geA[s] * (1.f / PV_SCALE); sgB[s] *= geB[s] * (1.f / PV_SCALE); }
    }
    if (RESYNC) xcd_barrier(bar);
    {
        OPAQUE_OFFS();
        float acc[4][16];
#pragma unroll
        for (int s = 0; s < 4; ++s)
#pragma unroll
            for (int k = 0; k < 16; ++k) acc[s][k] = 0.f;
        v4u rr[2][4];
#define PV_LOAD(st, SE, ln) { _Pragma("unroll") for (int s = 0; s < 4; ++s) { const int e_ = __builtin_amdgcn_readlane(SE[s], (ln)); ROW_DMA(PV, e_, (st) * 4 + s); } }
#define PV_FMA(buf, SG, ln) { _Pragma("unroll") for (int s = 0; s < 4; ++s) {                                                                                 \
                const float a_ = __builtin_bit_cast(float, __builtin_amdgcn_readlane(__builtin_bit_cast(int, SG[s]), (ln))); const v4u w_ = rr[buf][s];        \
                _Pragma("unroll") for (int q = 0; q < 4; ++q) { const f32x2 lo_ = __builtin_amdgcn_cvt_pk_f32_fp8((int)w_[q], false), hi_ = __builtin_amdgcn_cvt_pk_f32_fp8((int)w_[q], true);       \
                    acc[s][4 * q] += a_ * lo_.x; acc[s][4 * q + 1] += a_ * lo_.y; acc[s][4 * q + 2] += a_ * hi_.x; acc[s][4 * q + 3] += a_ * hi_.y; } } }
        asm volatile("s_waitcnt vmcnt(0)" ::: "memory");
        PV_LOAD(0, seA, 0) PV_LOAD(1, seB, 0) PV_LOAD(2, seA, 1)
        asm volatile("s_waitcnt vmcnt(8)" ::: "memory");
        ROW_READ(0, 0)
#pragma unroll 1
        for (int k = 0; k < 128; k += 4) {
            const int kh = k >> 1;
#pragma unroll
            for (int j = 0; j < 4; ++j) {
                { const int lj = kh + ((j + 3) >> 1), ln = lj < 63 ? lj : 63;
                  if ((j + 3) & 1) PV_LOAD((j + 3) % 4, seB, ln) else PV_LOAD((j + 3) % 4, seA, ln) }
                asm volatile("s_waitcnt vmcnt(8)" ::: "memory");
                ROW_READ((j + 1) & 1, (j + 1) % 4)
                if (j & 1) PV_FMA(j & 1, sgB, kh + (j >> 1)) else PV_FMA(j & 1, sgA, kh + (j >> 1))
            }
        }
        asm volatile("s_waitcnt vmcnt(0)" ::: "memory");
#undef PV_LOAD
#undef PV_FMA
#undef ROW_DMA
#undef ROW_READ
        asm volatile("" ::: "memory");
#pragma unroll
        for (int s = 0; s < 4; ++s) {
            asm volatile("" ::: "memory"); OPAQUE_OFFS();
            const int t = tbase + s; const int b = t / SEQ; const float* mrow = mod + b * 6 * D;
            float v[16]; float sm = 0.f;
#pragma unroll
            for (int q4 = 0; q4 < 4; ++q4) { const f32x4 xv = LDU(f32x4, X1 + (size_t)t * D + q4 * 4, l64); const f32x4 g2 = LDU(f32x4, mrow + 5 * D + q4 * 4, l64); const int k = q4 * 4;
                v[k] = ALPHA * xv.x + (1.f + g2.x) * acc[s][k]; v[k + 1] = ALPHA * xv.y + (1.f + g2.y) * acc[s][k + 1]; v[k + 2] = ALPHA * xv.z + (1.f + g2.z) * acc[s][k + 2]; v[k + 3] = ALPHA * xv.w + (1.f + g2.w) * acc[s][k + 3];
                sm += (v[k] + v[k + 1]) + (v[k + 2] + v[k + 3]); }
            const float mean = wave_sum(sm) * (1.f / D); float q = 0.f;
#pragma unroll
            for (int k = 0; k < 16; ++k) { v[k] -= mean; q += v[k] * v[k]; }
            const float rstd = rsqrtf(wave_sum(q) * (1.f / D) + LN_EPS);
#pragma unroll
            for (int q4 = 0; q4 < 4; ++q4) { const f32x4 gg = LDU(f32x4, ln2_g + q4 * 4, l64), bb = LDU(f32x4, ln2_b + q4 * 4, l64); const int k = q4 * 4;
                f32x4 o; o.x = v[k] * rstd * gg.x + bb.x; o.y = v[k + 1] * rstd * gg.y + bb.y; o.z = v[k + 2] * rstd * gg.z + bb.z; o.w = v[k + 3] * rstd * gg.w + bb.w;
                *(GAS f32x4*)((GAS char*)(out + (size_t)t * D + q4 * 4) + l64) = o; }
        }
    }
    if (RESYNC && hb == 0) xcd_barrier(bar);
    }
}
#ifndef MK_N_LAUNCHES
#define MK_N_LAUNCHES 1
#endif
constexpr int NPH = 11;
constexpr int N_LAUNCHES = MK_N_LAUNCHES;
static_assert(N_LAUNCHES == 1 || N_LAUNCHES == NPH, "MK_N_LAUNCHES is 1 or NPH");

struct Args { const float* in[18]; float* out; unsigned char* ws; int ph_lo, ph_hi; };

__global__ void __launch_bounds__(NTHR, 2) mk_fwd(Args args) {
    extern __shared__ __attribute__((aligned(16))) unsigned char lds_raw[];
    Ctx C;
    C.lds = (LAS unsigned char*)lds_raw;
    C.tid = threadIdx.x; C.lane = C.tid & 63; C.wave = __builtin_amdgcn_readfirstlane(C.tid >> 6);
    C.wg = blockIdx.x; C.G = gridDim.x; C.gw = C.wg * NWAVES + C.wave; C.NGW = C.G * NWAVES;
    volatile LAS unsigned* MISC = (volatile LAS unsigned*)(C.lds + MISC_OFF);
    for (int u = C.tid; u < (LDS_BYTES - LDSCTL_OFF) / 4; u += NTHR) ((LAS unsigned*)(C.lds + LDSCTL_OFF))[u] = 0u;
    __syncthreads();
    if (C.tid < A_COUNT) {
        const unsigned long long v = (C.tid < 18) ? (unsigned long long)args.in[C.tid < 18 ? C.tid : 0] : (C.tid == A_OUT ? (unsigned long long)args.out : (unsigned long long)args.ws);
        ((LAS unsigned long long*)(C.lds + ARGT_OFF))[C.tid] = v;
    }
    __syncthreads();
    unsigned* ctl = (unsigned*)(ARG_WS + WS_CTL);
    XcdBarrier bar; bar.bar = ctl + CW_BAR; bar.x = 0; bar.st = nullptr;
    if (N_LAUNCHES == 1) bar = xcd_barrier_post(ctl + CW_BAR, MISC + 8);
    const int lo = args.ph_lo, hi = args.ph_hi;
#ifndef PROBE_DUP
#define PROBE_DUP 0
#endif
#define IN(k) (lo <= (k) && (k) < hi)
#define REP(k) for (int rep_ = 0; rep_ < 1 + ((PROBE_DUP >> (k)) & 1); ++rep_)
#define SEAM(k) do { if (IN(k) && IN((k) + 1)) xcd_barrier(bar); } while (0)

    if (IN(0)) REP(0) { phase0(C); } SEAM(0);
    if (IN(1)) REP(1) { phase0b(C); } SEAM(1);
    if (IN(2)) REP(2) {
        pg8::Gemm g{(const pg8::bf16_t*)(ARG_WS + WS_H), (const pg8::bf16_t*)(ARG_WS + WS_WIN), M, NPROJ, D}; pg8::StaticOrder S; S.init(M, NPROJ, C.G, C.wg);
        pg8::EpiBf16<0> E{(pg8::bf16_t*)(ARG_WS + WS_PROJ), NPROJ, nullptr, 0, 0, 1.f};
        pg8::gemm_phase<pg8::EpiBf16<0>, pg8::StaticOrder, true, true>(C.lds, g, S, E);
        glr_simple(C);
    } SEAM(2);
    if (IN(3)) REP(3) { conv_phase(C); gla_pass_a(C); } SEAM(3);
    if (IN(4)) REP(4) { gla_scan(C); } SEAM(4);
    if (IN(5)) REP(5) { gla_pass_c(C); } SEAM(5);
    if (IN(6)) REP(6) {
        pg8::Gemm g{(const pg8::bf16_t*)(ARG_WS + WS_H), (const pg8::bf16_t*)(ARG_WS + WS_WOUT), M, D, D}; pg8::StaticOrder S; S.init(M, D, C.G, C.wg);
        EpiF32 E{ARG_OUT, D};
        pg8::gemm_phase<EpiF32, pg8::StaticOrder, true, true>(C.lds, g, S, E);
    } SEAM(6);
    if (IN(7)) REP(7) { ln1_phase(C); } SEAM(7);
    if (IN(8)) REP(8) {
        pg8::Gemm g{(const pg8::bf16_t*)(ARG_WS + WS_H2), (const pg8::bf16_t*)(ARG_WS + WS_WQ), M, NQ, D}; pg8::StaticOrder S; S.init(M, NQ, C.G, C.wg);
        pg8::EpiBf16<0> E{(pg8::bf16_t*)ARG_OUT, NQ, nullptr, 0, 0, 1.f};
        pg8::gemm_phase<pg8::EpiBf16<0>, pg8::StaticOrder, true, true>(C.lds, g, S, E);
    } SEAM(8);
    if (IN(9)) REP(9) { route_phase(C); } SEAM(9);
    if (IN(10)) REP(10) { peer_phase<0>(C, bar); }
#undef IN
#undef SEAM
}

extern "C" void kernel_launch(void* const* d_in, const int* in_sizes, int n_in, void* d_out, int out_size, void* d_ws, size_t ws_size, hipStream_t stream) {
    static int grid = 0;
    if (grid == 0) {
        int dev = 0, cus = 0;
        if (n_in != 18 || out_size != M * D || ws_size < 256 * MiB) { fprintf(stderr, "kernel_launch: unexpected problem (n_in %d out %d ws %zu)\n", n_in, out_size, ws_size); grid = -1; return; }
        if (hipGetDevice(&dev) != hipSuccess || hipDeviceGetAttribute(&cus, hipDeviceAttributeMultiprocessorCount, dev) != hipSuccess) { grid = -1; return; }
        if (hipFuncSetAttribute((const void*)mk_fwd, hipFuncAttributeMaxDynamicSharedMemorySize, LDS_BYTES) != hipSuccess) { fprintf(stderr, "kernel_launch: hipFuncSetAttribute failed\n"); grid = -1; return; }
        int per_cu = 0;
        (void)hipOccupancyMaxActiveBlocksPerMultiprocessor(&per_cu, (const void*)mk_fwd, NTHR, LDS_BYTES);
        (void)hipGetLastError();
        if (per_cu < 1) fprintf(stderr, "kernel_launch: occupancy query reports %d blocks per CU\n", per_cu);
        grid = cus;
    }
    if (grid < 0) return;
    (void)hipMemsetAsync((char*)d_ws + WS_CTL, 0, CTL_ZERO_BYTES, stream);
    Args a{};
    for (int i = 0; i < 18; ++i) a.in[i] = (const float*)d_in[i];
    a.out = (float*)d_out; a.ws = (unsigned char*)d_ws;
    for (int li = 0; li < N_LAUNCHES; ++li) {
        a.ph_lo = (N_LAUNCHES == 1) ? 0 : li; a.ph_hi = (N_LAUNCHES == 1) ? NPH : li + 1;
        hipLaunchKernelGGL(mk_fwd, dim3(grid), dim3(NTHR), LDS_BYTES, stream, a);
    }
}
```
